# Optimizing an MI355X kernel written in HIP

```python
import jax
import jax.numpy as jnp
from jax import lax
import numpy as np

D_MODEL = 1024
BATCH = 2
SEQ = 8192
DEPTH = 2

EPS = 1e-6
ML_HEADS = 4
ML_QK = 64
ML_V = 128
ML_CONV = 4
ML_CHUNK = 64
MLA_HEADS = 8
MLA_NOPE = 64
MLA_ROPE = 32
MLA_V = 64
MLA_Q_RANK = 256
MLA_KV_RANK = 128
ROPE_THETA = 10000.0
Q_BLOCK = 128
D_FF = 4 * D_MODEL

ML_WIDTH = ML_HEADS * ML_V
MLA_WIDTH = MLA_HEADS * MLA_V
MIX_WIDTH = ML_WIDTH + MLA_WIDTH
QK_COLS = 2 * ML_HEADS * ML_QK
GATE_COLS = 2 * ML_HEADS
IN_WIDTH = QK_COLS + 2 * ML_WIDTH + GATE_COLS + MLA_Q_RANK + MLA_KV_RANK + MLA_ROPE

kernel_name = 'hybrid_mlstm_mla_sandwich'


def rmsnorm(x, g):
    xf = x.astype(jnp.float32)
    y = xf * lax.rsqrt(jnp.mean(xf * xf, axis=-1, keepdims=True) + EPS)
    return (y * g.astype(jnp.float32)).astype(x.dtype)


def rope_tables(positions):
    inv = 1.0 / (ROPE_THETA ** (jnp.arange(0, MLA_ROPE, 2, dtype=jnp.float32) / MLA_ROPE))
    ang = positions.astype(jnp.float32)[..., None] * inv
    return jnp.cos(ang), jnp.sin(ang)


def apply_rope(x, cos, sin):
    xf = x.astype(jnp.float32)
    x1, x2 = jnp.split(xf, 2, axis=-1)
    return jnp.concatenate([x1 * cos - x2 * sin, x1 * sin + x2 * cos], axis=-1).astype(x.dtype)


def causal_conv(x, w, b):
    K = w.shape[0]
    S = x.shape[1]
    xp = jnp.pad(x, ((0, 0), (K - 1, 0), (0, 0)))
    return sum(xp[:, k:k + S] * w[k] for k in range(K)) + b


def mlstm_chunkwise(q, k, v, i_pre, f_pre):
    B, S, H, dk = q.shape
    dv = v.shape[-1]
    L = ML_CHUNK
    NC = S // L
    f32 = jnp.float32

    def chunk(t):
        t = t.reshape((B, NC, L, H) + t.shape[3:])
        return jnp.moveaxis(t, 3, 1)

    qc = chunk(q).astype(f32)
    kc = chunk(k).astype(f32) * (dk ** -0.5)
    vc = chunk(v).astype(f32)
    ig = chunk(i_pre).astype(f32)
    logf = jax.nn.log_sigmoid(chunk(f_pre).astype(f32))
    b = jnp.cumsum(logf, axis=-1)
    b_end = b[..., -1]

    a = b_end[..., None] - b + ig
    m_loc = jnp.max(a, axis=-1)
    w_loc = jnp.exp(a - m_loc[..., None])
    C_loc = jnp.einsum('bhcl,bhcld,bhcle->bhcde', w_loc, kc, vc)
    n_loc = jnp.einsum('bhcl,bhcld->bhcd', w_loc, kc)

    def step(carry, xs):
        C, n, m = carry
        Cl, nl, ml, bl = xs
        m_new = jnp.maximum(bl + m, ml)
        s_prev = jnp.exp(bl + m - m_new)
        s_loc = jnp.exp(ml - m_new)
        C_new = s_prev[..., None, None] * C + s_loc[..., None, None] * Cl
        n_new = s_prev[..., None] * n + s_loc[..., None] * nl
        return (C_new, n_new, m_new), (C, n, m)

    init = (jnp.zeros((B, H, dk, dv), f32), jnp.zeros((B, H, dk), f32), jnp.zeros((B, H), f32))
    xs = (jnp.moveaxis(C_loc, 2, 0), jnp.moveaxis(n_loc, 2, 0),
          jnp.moveaxis(m_loc, 2, 0), jnp.moveaxis(b_end, 2, 0))
    _, (C_prev, n_prev, m_prev) = lax.scan(step, init, xs)
    C_prev = jnp.moveaxis(C_prev, 0, 2)
    n_prev = jnp.moveaxis(n_prev, 0, 2)
    m_prev = jnp.moveaxis(m_prev, 0, 2)

    causal = jnp.tril(jnp.ones((L, L), dtype=bool))
    D = b[..., :, None] - b[..., None, :] + ig[..., None, :]
    D = jnp.where(causal, D, -jnp.inf)
    m_inter = b + m_prev[..., None]
    m_comb = jnp.maximum(jnp.max(D, axis=-1), m_inter)
    Dw = jnp.exp(D - m_comb[..., None])
    inter_w = jnp.exp(m_inter - m_comb)
    s = jnp.einsum('bhcid,bhcjd->bhcij', qc, kc) * Dw
    num = jnp.einsum('bhcij,bhcje->bhcie', s, vc) + inter_w[..., None] * jnp.einsum('bhcid,bhcde->bhcie', qc, C_prev)
    den = jnp.sum(s, axis=-1) + inter_w * jnp.einsum('bhcid,bhcd->bhci', qc, n_prev)
    h = num / jnp.maximum(jnp.abs(den), jnp.exp(-m_comb))[..., None]
    return jnp.moveaxis(h, 1, 3).reshape(B, S, H, dv)


def causal_block_attention(q, k, v):
    B, S, H, dq = q.shape
    dv = v.shape[-1]
    nb = S // Q_BLOCK
    scale = dq ** -0.5
    kf = k.astype(jnp.float32)
    vf = v.astype(jnp.float32)
    qb = jnp.transpose(q.reshape(B, nb, Q_BLOCK, H, dq), (1, 0, 3, 2, 4))
    kpos = jnp.arange(S)

    def one_block(args):
        qblk, bi = args
        sc = jnp.einsum('bhqd,bkhd->bhqk', qblk.astype(jnp.float32), kf) * scale
        qpos = bi * Q_BLOCK + jnp.arange(Q_BLOCK)
        sc = jnp.where(kpos[None, :] <= qpos[:, None], sc, -jnp.inf)
        p = jax.nn.softmax(sc, axis=-1)
        return jnp.einsum('bhqk,bkhd->bqhd', p, vf)

    out = lax.map(one_block, (qb, jnp.arange(nb)))
    return jnp.transpose(out, (1, 0, 2, 3, 4)).reshape(B, S, H * dv)


def token_mixer(a, cos, sin, w_in, b_gates, conv_w, conv_b, ml_head_norm,
                q_norm, w_uq, kv_norm, w_ukv, w_out):
    B, S, _ = a.shape
    proj = a @ w_in
    o0 = QK_COLS
    o1 = o0 + ML_WIDTH
    o2 = o1 + ML_WIDTH
    o3 = o2 + GATE_COLS
    o4 = o3 + MLA_Q_RANK
    o5 = o4 + MLA_KV_RANK
    qk_ml = proj[..., :o0]
    v_ml = proj[..., o0:o1]
    o_ml = proj[..., o1:o2]
    gates = proj[..., o2:o3] + b_gates
    c_q = proj[..., o3:o4]
    c_kv = proj[..., o4:o5]
    k_r = proj[..., o5:]

    qk_ml = jax.nn.silu(causal_conv(qk_ml, conv_w, conv_b))
    q_ml = qk_ml[..., :QK_COLS // 2].reshape(B, S, ML_HEADS, ML_QK)
    k_ml = qk_ml[..., QK_COLS // 2:].reshape(B, S, ML_HEADS, ML_QK)
    h_ml = mlstm_chunkwise(q_ml, k_ml, v_ml.reshape(B, S, ML_HEADS, ML_V),
                           gates[..., :ML_HEADS], gates[..., ML_HEADS:])
    h_ml = rmsnorm(h_ml, ml_head_norm.reshape(ML_HEADS, ML_V))
    h_ml = h_ml * jax.nn.sigmoid(o_ml.astype(jnp.float32)).reshape(B, S, ML_HEADS, ML_V)
    h_ml = h_ml.reshape(B, S, ML_WIDTH).astype(a.dtype)

    q = (rmsnorm(c_q, q_norm) @ w_uq).reshape(B, S, MLA_HEADS, MLA_NOPE + MLA_ROPE)
    q = jnp.concatenate([q[..., :MLA_NOPE],
                         apply_rope(q[..., MLA_NOPE:], cos[:, :, None, :], sin[:, :, None, :])], axis=-1)
    kv = (rmsnorm(c_kv, kv_norm) @ w_ukv).reshape(B, S, MLA_HEADS, MLA_NOPE + MLA_V)
    k_rope = apply_rope(k_r, cos, sin)[:, :, None, :]
    k = jnp.concatenate([kv[..., :MLA_NOPE],
                         jnp.broadcast_to(k_rope, (B, S, MLA_HEADS, MLA_ROPE))], axis=-1)
    h_mla = causal_block_attention(q, k, kv[..., MLA_NOPE:]).astype(a.dtype)

    return jnp.concatenate([h_ml, h_mla], axis=-1) @ w_out


def setup_inputs(seed: int = 0) -> dict:
    key = jax.random.key(seed)
    ks = jax.random.split(key, 20)

    def nrm(k, shape, scale):
        return jax.random.normal(k, shape, jnp.float32) * scale

    def gain(k, shape):
        return 1.0 + 0.05 * jax.random.normal(k, shape, jnp.float32)

    x = nrm(ks[0], (BATCH, SEQ, D_MODEL), 1.0)
    positions = jnp.broadcast_to(jnp.arange(SEQ, dtype=jnp.int32), (BATCH, SEQ))
    b_gates = jnp.concatenate([nrm(ks[3], (DEPTH, ML_HEADS), 0.1),
                               3.0 + nrm(ks[4], (DEPTH, ML_HEADS), 0.1)], axis=-1)
    return {
        'x': x,
        'positions': positions,
        'norm_pre_mix': gain(ks[1], (DEPTH, D_MODEL)),
        'w_in': nrm(ks[2], (DEPTH, D_MODEL, IN_WIDTH), D_MODEL ** -0.5),
        'b_gates': b_gates,
        'conv_w': nrm(ks[5], (DEPTH, ML_CONV, QK_COLS), ML_CONV ** -0.5),
        'conv_b': nrm(ks[6], (DEPTH, QK_COLS), 0.02),
        'ml_head_norm': gain(ks[7], (DEPTH, ML_WIDTH)),
        'q_norm': gain(ks[8], (DEPTH, MLA_Q_RANK)),
        'w_uq': nrm(ks[9], (DEPTH, MLA_Q_RANK, MLA_HEADS * (MLA_NOPE + MLA_ROPE)), MLA_Q_RANK ** -0.5),
        'kv_norm': gain(ks[10], (DEPTH, MLA_KV_RANK)),
        'w_ukv': nrm(ks[11], (DEPTH, MLA_KV_RANK, MLA_HEADS * (MLA_NOPE + MLA_V)), MLA_KV_RANK ** -0.5),
        'w_out': nrm(ks[12], (DEPTH, MIX_WIDTH, D_MODEL), MIX_WIDTH ** -0.5),
        'norm_post_mix': gain(ks[13], (DEPTH, D_MODEL)),
        'norm_pre_mlp': gain(ks[14], (DEPTH, D_MODEL)),
        'w_up': nrm(ks[15], (DEPTH, D_MODEL, D_FF), D_MODEL ** -0.5),
        'w_down': nrm(ks[16], (DEPTH, D_FF, D_MODEL), D_FF ** -0.5),
        'norm_post_mlp': gain(ks[17], (DEPTH, D_MODEL)),
    }


def reference(x, positions, norm_pre_mix, w_in, b_gates, conv_w, conv_b, ml_head_norm,
              q_norm, w_uq, kv_norm, w_ukv, w_out, norm_post_mix, norm_pre_mlp,
              w_up, w_down, norm_post_mlp):
    cos, sin = rope_tables(positions)
    for l in range(DEPTH):
        a = rmsnorm(x, norm_pre_mix[l])
        mix = token_mixer(a, cos, sin, w_in[l], b_gates[l], conv_w[l], conv_b[l], ml_head_norm[l],
                          q_norm[l], w_uq[l], kv_norm[l], w_ukv[l], w_out[l])
        x = x + rmsnorm(mix, norm_post_mix[l])
        m = rmsnorm(x, norm_pre_mlp[l])
        y = jnp.square(jax.nn.relu(m @ w_up[l])) @ w_down[l]
        x = x + rmsnorm(y, norm_post_mlp[l])
    return x
```

```cpp
#include <hip/hip_runtime.h>
#include <hip/hip_cooperative_groups.h>
#include <cstdio>
#include <cstdint>
namespace cg = cooperative_groups;
namespace pg8 {
#define PG8_LAS __attribute__((address_space(3)))
typedef unsigned short bf16_t;
typedef short bf16x8 __attribute__((ext_vector_type(8)));
typedef float f32x4 __attribute__((ext_vector_type(4)));
typedef unsigned u32x4 __attribute__((ext_vector_type(4)));
constexpr int BM = 256, BK = 64, HALF = 128, HTB = HALF * BK * 2  , STAGE_BYTES = 8 * HTB, NXCD = 8, WGM = 8;

__host__ __device__ __forceinline__ int lds_byte(int r, int c) { const int st = (r >> 4) * 2 + (c >> 5), rr = r & 15, cc = c & 31, ob = rr * 64 + cc * 2; return st * 1024 + (ob ^ (((ob >> 9) & 1) << 5)); }
__host__ __device__ __forceinline__ void stage_rc(int b, int& R, int& C) { const int st = b / 1024, sb = b % 1024, swz = sb ^ (((sb >> 9) & 1) << 5); R = (st >> 1) * 16 + swz / 64; C = (st & 1) * 32 + (swz % 64) / 2; }
__host__ __device__ __forceinline__ int perm32(int rho) { const int n = rho >> 4, i = rho & 15; return 8 * (i >> 2) + 4 * n + (i & 3); }

struct Unit { int pm, pn; };
struct Gemm { const bf16_t* A; const bf16_t* Bt; int M, N, K; };

struct StaticOrder {
    int nM, nN, nwg, G, c;
    __host__ __device__ void init(int M, int N, int G_, int c_) { nM = M / BM; nN = N / BM; nwg = nM * nN; G = G_; c = c_; }
    __host__ __device__ bool next(int i, Unit& u) const {
        const long L = (long)i * G + c; if (L >= nwg) return false;
        int wgid = (int)L; { const int q = nwg / NXCD, r = nwg % NXCD, xcd = wgid % NXCD, off = wgid / NXCD; wgid = (xcd < r ? xcd * (q + 1) : r * (q + 1) + (xcd - r) * q) + off; }
        const int nig = WGM * nN, gid = wgid / nig, fm = gid * WGM, gsz = (nM - fm) < WGM ? (nM - fm) : WGM;
        u.pm = fm + ((wgid % nig) % gsz); u.pn = (wgid % nig) / gsz; return true;
    }
    __device__ __forceinline__ void a_ready(const Unit&) const {}
    __device__ __forceinline__ void done(const Unit&) const {}
};


__device__ __forceinline__ unsigned cvt_pk_bf16(float lo, float hi) { unsigned r; asm volatile("v_cvt_pk_bf16_f32 %0, %1, %2" : "=v"(r) : "v"(lo), "v"(hi)); return r; }

template <class Epi, class Sched, bool ALIGN_EPI = false, bool SP2 = false>
__device__ __forceinline__ void gemm_phase(PG8_LAS unsigned char* lds, const Gemm g, const Sched& S, const Epi& E, const int wave_s) {
    unsigned ones_l = ~0u; asm volatile("" : "+s"(ones_l));
    const int tid = wave_s * 64 + (int)__builtin_amdgcn_mbcnt_hi(ones_l, __builtin_amdgcn_mbcnt_lo(ones_l, 0u)), wid = __builtin_amdgcn_readfirstlane(tid >> 6), lane = tid & 63, wr = wid >> 2, wc = wid & 3, fr = lane & 15, fq = lane >> 4;
    const int K = g.K, nt = K / BK;
    unsigned voffA[2], voffB[2];
#pragma unroll
    for (int i = 0; i < 2; ++i) { int R, C; stage_rc(tid * 16 + i * 8192, R, C); const int Rb = Epi::PERM ? ((R & ~31) + perm32(R & 31)) : R;
        voffA[i] = (unsigned)(R * K + C) * 2u; voffB[i] = (unsigned)(Rb * K + C) * 2u; }
    const size_t kstep = (size_t)(BK * 2);
    const size_t hstep = (size_t)HALF * K * 2;
    const size_t tstep = 2 * hstep;
    const unsigned ldsw = (unsigned)wid * 1024u;
    const int aoff = lds_byte(wr * 64 + fr, fq * 8), boff = lds_byte(wc * 32 + fr, fq * 8);
#define PG8_SA(b, h) (((b) * 2 + (h)) * HTB)
#define PG8_SB(b, h) ((4 + (b) * 2 + (h)) * HTB)
#define PG8_STAGE(bufoff, gbase, voff) do { _Pragma("unroll") for (int _i = 0; _i < 2; ++_i) \
        __builtin_amdgcn_global_load_lds((const unsigned*)((const char*)(gbase) + (voff)[_i]), (PG8_LAS unsigned*)(lds + (bufoff) + ldsw + _i * 8192), 16, 0, 0); } while (0)
#define PG8_LDA(dst, b, h) do { _Pragma("unroll") for (int m = 0; m < 4; ++m) _Pragma("unroll") for (int k = 0; k < 2; ++k) dst[m][k] = *(const PG8_LAS bf16x8*)(lds + PG8_SA(b, h) + aoff + m * 2048 + k * 1024); } while (0)
#define PG8_LDB(dst, b, h) do { _Pragma("unroll") for (int n = 0; n < 2; ++n) _Pragma("unroll") for (int k = 0; k < 2; ++k) dst[n][k] = *(const PG8_LAS bf16x8*)(lds + PG8_SB(b, h) + boff + n * 2048 + k * 1024); } while (0)
#define PG8_MMA(ai, bj, At, Bt) do { __builtin_amdgcn_s_setprio(1); _Pragma("unroll") for (int m = 0; m < 4; ++m) _Pragma("unroll") for (int n = 0; n < 2; ++n) _Pragma("unroll") for (int k = 0; k < 2; ++k) \
        acc[ai][bj][m][n] = __builtin_amdgcn_mfma_f32_16x16x32_bf16(Bt[n][k], At[m][k], acc[ai][bj][m][n], 0, 0, 0); __builtin_amdgcn_s_setprio(0); } while (0)
#define PG8_WAIT_V(n) asm volatile("s_waitcnt vmcnt(" #n ")" ::: "memory")
#define PG8_WAIT_L(n) asm volatile("s_waitcnt lgkmcnt(" #n ")" ::: "memory")
#define PG8_BAR __builtin_amdgcn_s_barrier()
#define PG8_SCHED __builtin_amdgcn_sched_barrier(0)
    Unit cur, nxt; int ui = 0;
    if (!S.next(0, cur)) return;
    f32x4 acc[2][2][4][2];
#pragma unroll
    for (int a = 0; a < 2; ++a)
#pragma unroll
        for (int b = 0; b < 2; ++b)
#pragma unroll
            for (int m = 0; m < 4; ++m)
#pragma unroll
                for (int n = 0; n < 2; ++n) acc[a][b][m][n] = (f32x4){0.f, 0.f, 0.f, 0.f};
    bf16x8 At[4][2], B0[2][2], B1[2][2];
    const char* cA = (const char*)g.A + (size_t)cur.pm * tstep; const char* cB = (const char*)g.Bt + (size_t)cur.pn * tstep;
    S.a_ready(cur);
    if constexpr (SP2) {
        PG8_STAGE(PG8_SB(0, 0), cB, voffB); PG8_STAGE(PG8_SB(0, 1), cB + hstep, voffB); PG8_STAGE(PG8_SA(0, 0), cA, voffA); PG8_STAGE(PG8_SA(0, 1), cA + hstep, voffA);
        if (wr == 1) PG8_BAR;
        PG8_WAIT_V(2); PG8_BAR;
        PG8_STAGE(PG8_SB(1, 0), cB + kstep, voffB); PG8_STAGE(PG8_SA(1, 0), cA + kstep, voffA); PG8_STAGE(PG8_SB(1, 1), cB + hstep + kstep, voffB);
        PG8_WAIT_V(6); PG8_BAR;
    } else {
        PG8_STAGE(PG8_SB(0, 0), cB, voffB); PG8_STAGE(PG8_SA(0, 0), cA, voffA); PG8_STAGE(PG8_SB(0, 1), cB + hstep, voffB); PG8_STAGE(PG8_SA(0, 1), cA + hstep, voffA);
        if (wr == 1) PG8_BAR;
        PG8_WAIT_V(4); PG8_BAR;
        PG8_STAGE(PG8_SB(1, 0), cB + kstep, voffB); PG8_STAGE(PG8_SA(1, 0), cA + kstep, voffA); PG8_STAGE(PG8_SB(1, 1), cB + hstep + kstep, voffB);
        PG8_WAIT_V(6); PG8_BAR;
    }
    for (;;) {
        const bool has_next = S.next(ui + 1, nxt);
        const char* nA = has_next ? (const char*)g.A + (size_t)nxt.pm * tstep : cA; const char* nB = has_next ? (const char*)g.Bt + (size_t)nxt.pn * tstep : cB;
        for (int t = 0; t < nt; t += 2) {
            const bool last = (t == nt - 2);
            const char* a1 = cA + (size_t)(t + 1) * kstep;
            const char* a2 = last ? nA : cA + (size_t)(t + 2) * kstep; const char* b2 = last ? nB : cB + (size_t)(t + 2) * kstep;
            const char* a3 = a2 + kstep; const char* b3 = b2 + kstep;
            if (last && has_next) S.a_ready(nxt);
            if constexpr (SP2) {
            PG8_LDB(B0, 0, 0); PG8_LDB(B1, 0, 1); PG8_SCHED; PG8_LDA(At, 0, 0); PG8_STAGE(PG8_SA(1, 1), a1 + hstep, voffA);
            PG8_WAIT_V(8); PG8_WAIT_L(0); PG8_BAR; PG8_MMA(0, 0, At, B0); PG8_MMA(0, 1, At, B1); PG8_BAR; PG8_SCHED;
            PG8_LDA(At, 0, 1); PG8_STAGE(PG8_SB(0, 0), b2, voffB); PG8_STAGE(PG8_SB(0, 1), b2 + hstep, voffB); PG8_STAGE(PG8_SA(0, 0), a2, voffA);
            PG8_WAIT_V(8); PG8_WAIT_L(0); PG8_BAR; PG8_MMA(1, 0, At, B0); PG8_MMA(1, 1, At, B1); PG8_BAR; PG8_SCHED;
            PG8_LDB(B0, 1, 0); PG8_LDB(B1, 1, 1); PG8_SCHED; PG8_LDA(At, 1, 0); PG8_STAGE(PG8_SA(0, 1), a2 + hstep, voffA);
            PG8_WAIT_V(8); PG8_WAIT_L(0); PG8_BAR; PG8_MMA(0, 0, At, B0); PG8_MMA(0, 1, At, B1); PG8_BAR; PG8_SCHED;
            PG8_LDA(At, 1, 1); PG8_STAGE(PG8_SB(1, 0), b3, voffB); PG8_STAGE(PG8_SB(1, 1), b3 + hstep, voffB); PG8_STAGE(PG8_SA(1, 0), a3, voffA);
            PG8_WAIT_V(8); PG8_WAIT_L(0); PG8_BAR; PG8_MMA(1, 0, At, B0); PG8_MMA(1, 1, At, B1); PG8_BAR; PG8_SCHED;
            } else {
            PG8_LDB(B0, 0, 0); PG8_SCHED; PG8_LDA(At, 0, 0); PG8_STAGE(PG8_SA(1, 1), a1 + hstep, voffA);
            PG8_WAIT_L(8); PG8_BAR; PG8_WAIT_L(0); PG8_MMA(0, 0, At, B0); PG8_BAR; PG8_SCHED;
            PG8_LDB(B1, 0, 1); PG8_STAGE(PG8_SB(0, 0), b2, voffB);
            PG8_BAR; PG8_WAIT_L(0); PG8_MMA(0, 1, At, B1); PG8_BAR;
            PG8_LDA(At, 0, 1); PG8_STAGE(PG8_SA(0, 0), a2, voffA);
            PG8_BAR; PG8_WAIT_L(0); PG8_MMA(1, 0, At, B0); PG8_BAR; PG8_SCHED;
            PG8_STAGE(PG8_SB(0, 1), b2 + hstep, voffB);
            PG8_WAIT_V(6); PG8_BAR; PG8_MMA(1, 1, At, B1); PG8_BAR;
            PG8_LDB(B0, 1, 0); PG8_SCHED; PG8_LDA(At, 1, 0); PG8_STAGE(PG8_SA(0, 1), a2 + hstep, voffA);
            PG8_WAIT_L(8); PG8_BAR; PG8_WAIT_L(0); PG8_MMA(0, 0, At, B0); PG8_BAR; PG8_SCHED;
            PG8_LDB(B1, 1, 1); PG8_STAGE(PG8_SB(1, 0), b3, voffB);
            PG8_BAR; PG8_WAIT_L(0); PG8_MMA(0, 1, At, B1); PG8_BAR;
            PG8_LDA(At, 1, 1); PG8_STAGE(PG8_SA(1, 0), a3, voffA);
            PG8_BAR; PG8_WAIT_L(0); PG8_MMA(1, 0, At, B0); PG8_BAR; PG8_SCHED;
            PG8_STAGE(PG8_SB(1, 1), b3 + hstep, voffB);
            PG8_WAIT_V(6); PG8_BAR; PG8_MMA(1, 1, At, B1); PG8_BAR;
            }
        }
        if constexpr (ALIGN_EPI) { if (wr == 0) PG8_BAR; }
        if constexpr (!Epi::AFTER_DRAIN) { E(acc, cur, wr, wc, fr, fq); S.done(cur); }
        if (!has_next) break;
#pragma unroll
        for (int a = 0; a < 2; ++a)
#pragma unroll
            for (int b = 0; b < 2; ++b)
#pragma unroll
                for (int m = 0; m < 4; ++m)
#pragma unroll
                    for (int n = 0; n < 2; ++n) acc[a][b][m][n] = (f32x4){0.f, 0.f, 0.f, 0.f};
        cur = nxt; cA = nA; cB = nB; ++ui;
        if constexpr (ALIGN_EPI) { if (wr == 1) PG8_BAR; }
    }
    PG8_WAIT_V(0);
    if constexpr (!ALIGN_EPI) { if (wr == 0) PG8_BAR; }
    PG8_BAR;
    if constexpr (Epi::AFTER_DRAIN) { E.fused(acc, cur, wr, wc, fr, fq, lds, wid, lane); S.done(cur); }
#undef PG8_SA
#undef PG8_SB
#undef PG8_STAGE
#undef PG8_LDA
#undef PG8_LDB
#undef PG8_MMA
#undef PG8_WAIT_V
#undef PG8_WAIT_L
#undef PG8_BAR
#undef PG8_SCHED
}
}


#define DI __device__ __forceinline__
typedef unsigned short bf16_t;
typedef short bf16x8 __attribute__((ext_vector_type(8)));
typedef short s16x4 __attribute__((ext_vector_type(4)));
typedef float f32x4 __attribute__((ext_vector_type(4)));
typedef float f32x16 __attribute__((ext_vector_type(16)));
typedef unsigned u32x4 __attribute__((ext_vector_type(4)));
typedef unsigned u32x2 __attribute__((ext_vector_type(2)));

constexpr int BATCH = 2, SEQ = 8192, DM = 1024, M = BATCH * SEQ, DEPTH = 2, FF = 4096;
constexpr int NPROJ = 2048, INW = 1960;
constexpr int C_QK = 0, C_V = 512, C_O = 1024, C_G = 1536, C_CQ = 1544, C_CKV = 1800, C_KR = 1928;
constexpr int NCH = 128;
constexpr float EPS = 1e-6f;
constexpr float QSCALE = 0.10206207261596575f * 1.4426950408889634f;
constexpr int NWAVES = 8, NTHR = 512;

constexpr size_t MiB = 1u << 20;
constexpr size_t WS_MLOC = 0, WS_BEND = 4096, WS_MPREV = 8192, WS_NLOC = 65536;
constexpr size_t WS_W = 1 * MiB, W_LAYER = 23 * MiB;
constexpr size_t W_IN = 0, W_UQ = 4 * MiB, W_UKV = 4 * MiB + 512 * 1024, W_OUT = 5 * MiB, W_UP = 7 * MiB, W_DOWN = 15 * MiB;
constexpr size_t WS_COS = 47 * MiB, WS_SIN = 48 * MiB;
constexpr size_t WS_XN = 50 * MiB, WS_CS = 50 * MiB;
constexpr size_t WS_H = 82 * MiB;
constexpr size_t WS_PROJ = 82 * MiB, WS_Q = 146 * MiB, WS_K = 170 * MiB, WS_VT = 194 * MiB;
constexpr size_t WS_MIX = 82 * MiB;
constexpr size_t WS_HM = 210 * MiB, WS_Y = 210 * MiB;
constexpr size_t WS_CQN = 242 * MiB, WS_CKVN = 250 * MiB, WS_END = 254 * MiB;
constexpr int LDS_BYTES = 147456;

DI float bf2f(bf16_t v) { return __uint_as_float((unsigned)v << 16); }
DI float bflo(unsigned w) { return __uint_as_float(w << 16); }
DI float bfhi(unsigned w) { return __uint_as_float(w & 0xffff0000u); }
typedef float f32x2_t __attribute__((ext_vector_type(2))); typedef __bf16 bf16x2_t __attribute__((ext_vector_type(2)));
DI unsigned pk2(float lo, float hi) { f32x2_t v = {lo, hi}; bf16x2_t b = __builtin_convertvector(v, bf16x2_t); return __builtin_bit_cast(unsigned, b); }
DI bf16_t f2bf(float f) { return (bf16_t)(pk2(f, 0.f) & 0xffffu); }
DI float wave_sum(float v) {
#pragma unroll
    for (int o = 1; o < 64; o <<= 1) v += __shfl_xor(v, o);
    return v;
}
DI float wave_max(float v) {
#pragma unroll
    for (int o = 1; o < 64; o <<= 1) v = fmaxf(v, __shfl_xor(v, o));
    return v;
}
DI int crow(int reg, int h) { return (reg & 3) + 8 * (reg >> 2) + 4 * h; }
DI int tid_opaque(int wave_s) { unsigned ones_l = ~0u; asm volatile("" : "+s"(ones_l)); return wave_s * 64 + (int)__builtin_amdgcn_mbcnt_hi(ones_l, __builtin_amdgcn_mbcnt_lo(ones_l, 0u)); }
#define MFMA32(a, b, c) __builtin_amdgcn_mfma_f32_32x32x16_bf16((a), (b), (c), 0, 0, 0)
#define LDSFENCE() asm volatile("s_waitcnt lgkmcnt(0)" ::: "memory")

template <int ACT  > struct EpiStore {
    static constexpr bool PERM = true, AFTER_DRAIN = false;
    bf16_t* O; int ldc;
    DI void operator()(const pg8::f32x4 (&acc)[2][2][4][2], const pg8::Unit& u, int wr, int wc, int fr, int fq) const {
#pragma unroll
        for (int ai = 0; ai < 2; ++ai)
#pragma unroll
            for (int m = 0; m < 4; ++m) {
                const int row = u.pm * 256 + ai * 128 + wr * 64 + m * 16 + fr;
#pragma unroll
                for (int bj = 0; bj < 2; ++bj) {
                    const int col0 = u.pn * 256 + bj * 128 + wc * 32 + 8 * fq;
                    pg8::f32x4 v0 = acc[ai][bj][m][0], v1 = acc[ai][bj][m][1];
                    if (ACT == 2) {
#pragma unroll
                        for (int e = 0; e < 4; ++e) { float a = fmaxf(v0[e], 0.f), b = fmaxf(v1[e], 0.f); v0[e] = a * a; v1[e] = b * b; }
                    }
                    u32x4 w; w.x = pk2(v0[0], v0[1]); w.y = pk2(v0[2], v0[3]); w.z = pk2(v1[0], v1[1]); w.w = pk2(v1[2], v1[3]);
                    *(u32x4*)(O + (size_t)row * ldc + col0) = w;
                }
            }
    }
};
struct EpiQ {
    static constexpr bool PERM = true, AFTER_DRAIN = false;
    bf16_t* Q; const float* COS; const float* SIN;
    DI void operator()(const pg8::f32x4 (&acc)[2][2][4][2], const pg8::Unit& u, int wr, int wc, int fr, int fq) const {
#pragma unroll
        for (int bj = 0; bj < 2; ++bj) {
            const int cbase = u.pn * 256 + bj * 128 + wc * 32;
            const int col0 = cbase + 8 * fq;
            const bool rope = ((cbase >> 5) % 3) == 2;
#pragma unroll
            for (int ai = 0; ai < 2; ++ai)
#pragma unroll
                for (int m = 0; m < 4; ++m) {
                    const int row = u.pm * 256 + ai * 128 + wr * 64 + m * 16 + fr;
                    pg8::f32x4 v0 = acc[ai][bj][m][0], v1 = acc[ai][bj][m][1];
                    if (rope) {
                        pg8::f32x4 o0, o1;
#pragma unroll
                        for (int e = 0; e < 4; ++e) { o0[e] = __shfl_xor(v0[e], 32); o1[e] = __shfl_xor(v1[e], 32); }
                        const int i0 = 8 * (fq & 1);
                        const pg8::f32x4 c0 = *(const pg8::f32x4*)(COS + (size_t)row * 16 + i0), c1 = *(const pg8::f32x4*)(COS + (size_t)row * 16 + i0 + 4);
                        const pg8::f32x4 s0 = *(const pg8::f32x4*)(SIN + (size_t)row * 16 + i0), s1 = *(const pg8::f32x4*)(SIN + (size_t)row * 16 + i0 + 4);
                        if (fq < 2) { v0 = v0 * c0 - o0 * s0; v1 = v1 * c1 - o1 * s1; }
                        else        { v0 = o0 * s0 + v0 * c0; v1 = o1 * s1 + v1 * c1; }
                    }
                    v0 = v0 * QSCALE; v1 = v1 * QSCALE;
                    u32x4 w; w.x = pk2(v0[0], v0[1]); w.y = pk2(v0[2], v0[3]); w.z = pk2(v1[0], v1[1]); w.w = pk2(v1[2], v1[3]);
                    *(u32x4*)(Q + (size_t)row * 768 + col0) = w;
                }
        }
    }
};
struct EpiKV {
    static constexpr bool PERM = true, AFTER_DRAIN = false;
    bf16_t* Kb; bf16_t* VT;
    DI void operator()(const pg8::f32x4 (&acc)[2][2][4][2], const pg8::Unit& u, int wr, int wc, int fr, int fq) const {
#pragma unroll
        for (int bj = 0; bj < 2; ++bj) {
            const int head = u.pn * 2 + bj, w0 = wc * 32 + 8 * fq;
#pragma unroll
            for (int ai = 0; ai < 2; ++ai)
#pragma unroll
                for (int m = 0; m < 4; ++m) {
                    const int row = u.pm * 256 + ai * 128 + wr * 64 + m * 16 + fr;
                    const pg8::f32x4 v0 = acc[ai][bj][m][0], v1 = acc[ai][bj][m][1];
                    if (wc < 2) {
                        u32x4 w; w.x = pk2(v0[0], v0[1]); w.y = pk2(v0[2], v0[3]); w.z = pk2(v1[0], v1[1]); w.w = pk2(v1[2], v1[3]);
                        *(u32x4*)(Kb + (size_t)row * 768 + head * 96 + w0) = w;
                    } else {
                        const int b = row >> 13, s = row & (SEQ - 1);
                        bf16_t* base = VT + ((size_t)((b * 8 + head) * 64 + (w0 - 64))) * SEQ + s;
#pragma unroll
                        for (int e = 0; e < 4; ++e) { base[(size_t)e * SEQ] = f2bf(v0[e]); base[(size_t)(4 + e) * SEQ] = f2bf(v1[e]); }
                    }
                }
        }
    }
};

DI void transpose_item(const float* W, int K, int N, int Npad, bf16_t* WT, float* scr, int item, int lane) {
    const int nblk = Npad / 32, kb = item / nblk, nb = item % nblk, k0 = 64 * kb, n0 = 32 * nb;
    const int n = n0 + (lane & 31);
#pragma unroll 8
    for (int i = 0; i < 32; ++i) { const int kk = 2 * i + (lane >> 5); scr[kk * 33 + (lane & 31)] = (n < N) ? W[(size_t)(k0 + kk) * N + n] : 0.f; }
    LDSFENCE();
    const int c = lane & 7;
#pragma unroll
    for (int j = 0; j < 4; ++j) { const int nn = (lane >> 3) + 8 * j; const float* s = scr + (8 * c) * 33 + nn;
        u32x4 o; o.x = pk2(s[0 * 33], s[1 * 33]); o.y = pk2(s[2 * 33], s[3 * 33]); o.z = pk2(s[4 * 33], s[5 * 33]); o.w = pk2(s[6 * 33], s[7 * 33]);
        *(u32x4*)(WT + (size_t)(n0 + nn) * K + k0 + 8 * c) = o; }
    LDSFENCE();
}
DI void row_pass(const bf16_t* src, const float* xin, const float* gpost, float* xout, const float* gnext, bf16_t* XN, int gw, int NGW, int lane) {
    for (int m = gw; m < M; m += NGW) {
        f32x4 xv[4];
#pragma unroll
        for (int j = 0; j < 4; ++j) xv[j] = *(const f32x4*)(xin + (size_t)m * DM + 4 * lane + 256 * j);
        if (src) {
            f32x4 bv[4]; float ss = 0.f;
#pragma unroll
            for (int j = 0; j < 4; ++j) { const u32x2 w = *(const u32x2*)(src + (size_t)m * DM + 4 * lane + 256 * j);
                bv[j] = (f32x4){bflo(w.x), bfhi(w.x), bflo(w.y), bfhi(w.y)}; ss += (bv[j].x * bv[j].x + bv[j].y * bv[j].y) + (bv[j].z * bv[j].z + bv[j].w * bv[j].w); }
            ss = wave_sum(ss); const float rs = rsqrtf(ss * (1.f / DM) + EPS);
#pragma unroll
            for (int j = 0; j < 4; ++j) { const f32x4 g = *(const f32x4*)(gpost + 4 * lane + 256 * j); xv[j] = xv[j] + bv[j] * rs * g;
                *(f32x4*)(xout + (size_t)m * DM + 4 * lane + 256 * j) = xv[j]; }
        }
        if (gnext) {
            float s2 = 0.f;
#pragma unroll
            for (int j = 0; j < 4; ++j) s2 += (xv[j].x * xv[j].x + xv[j].y * xv[j].y) + (xv[j].z * xv[j].z + xv[j].w * xv[j].w);
            s2 = wave_sum(s2); const float rs2 = rsqrtf(s2 * (1.f / DM) + EPS);
#pragma unroll
            for (int j = 0; j < 4; ++j) { const f32x4 g = *(const f32x4*)(gnext + 4 * lane + 256 * j); const f32x4 v = xv[j] * rs2 * g;
                u32x2 o; o.x = pk2(v.x, v.y); o.y = pk2(v.z, v.w); *(u32x2*)(XN + (size_t)m * DM + 4 * lane + 256 * j) = o; }
        }
    }
}
DI void rope_tables(const int* positions, float* COS, float* SIN, int gtid, int NT) {
    for (int idx = gtid; idx < M * 16; idx += NT) {
        const int m = idx >> 4, i = idx & 15;
        double inv = (i & 3) == 0 ? 1.0 : ((i & 3) == 1 ? 0.5623413251903491 : ((i & 3) == 2 ? 0.31622776601683794 : 0.1778279410038923));
        const int dec = i >> 2; inv *= (dec == 0 ? 1.0 : (dec == 1 ? 0.1 : (dec == 2 ? 0.01 : 0.001)));
        const float ang_f = (float)positions[m] * (float)inv;
        const double ang = (double)ang_f;
        const double k = rint(ang * 0.15915494309189535); const double rr = ang - k * 6.283185307179586;
        const double hq = rr * 0.25, x2 = hq * hq;
        const double s = hq * (1.0 - x2 / 6.0 * (1.0 - x2 / 20.0 * (1.0 - x2 / 42.0 * (1.0 - x2 / 72.0 * (1.0 - x2 / 110.0 * (1.0 - x2 / 156.0))))));
        const double c = 1.0 - x2 / 2.0 * (1.0 - x2 / 12.0 * (1.0 - x2 / 30.0 * (1.0 - x2 / 56.0 * (1.0 - x2 / 90.0 * (1.0 - x2 / 132.0)))));
        const double s2 = 2.0 * s * c, c2 = 1.0 - 2.0 * s * s; const double s4 = 2.0 * s2 * c2, c4 = 1.0 - 2.0 * s2 * s2;
        COS[idx] = (float)c4; SIN[idx] = (float)s4;
    }
}
DI void prep_rows(const bf16_t* PROJ, const float* qn, const float* kvn, const float* COS, const float* SIN, bf16_t* CQN, bf16_t* CKVN, bf16_t* Kb, int gw, int NGW, int lane) {
    for (int m = gw; m < M; m += NGW) {
        const bf16_t* pr = PROJ + (size_t)m * NPROJ;
        { const u32x2 w = *(const u32x2*)(pr + C_CQ + 4 * lane); const float c0 = bflo(w.x), c1 = bfhi(w.x), c2 = bflo(w.y), c3 = bfhi(w.y);
          const float ss = wave_sum((c0 * c0 + c1 * c1) + (c2 * c2 + c3 * c3)); const float rs = rsqrtf(ss * (1.f / 256.f) + EPS);
          const f32x4 g = *(const f32x4*)(qn + 4 * lane);
          u32x2 o; o.x = pk2(c0 * rs * g.x, c1 * rs * g.y); o.y = pk2(c2 * rs * g.z, c3 * rs * g.w); *(u32x2*)(CQN + (size_t)m * 256 + 4 * lane) = o; }
        { const unsigned w = *(const unsigned*)(pr + C_CKV + 2 * lane); const float c0 = bflo(w), c1 = bfhi(w);
          const float ss = wave_sum(c0 * c0 + c1 * c1); const float rs = rsqrtf(ss * (1.f / 128.f) + EPS);
          *(unsigned*)(CKVN + (size_t)m * 128 + 2 * lane) = pk2(c0 * rs * kvn[2 * lane], c1 * rs * kvn[2 * lane + 1]); }
        { const int i = lane & 15; const float x1 = bf2f(pr[C_KR + i]), x2 = bf2f(pr[C_KR + 16 + i]); const float c = COS[(size_t)m * 16 + i], s = SIN[(size_t)m * 16 + i];
          const float o = (lane & 16) ? (x1 * s + x2 * c) : (x1 * c - x2 * s);
          if (lane < 32) { const bf16_t ob = f2bf(o);
#pragma unroll
              for (int hh = 0; hh < 8; ++hh) Kb[(size_t)m * 768 + hh * 96 + 64 + lane] = ob; } }
    }
}

constexpr int AK_STRIDE = 208, AV_STRIDE = 136, AK_BYTES = 64 * AK_STRIDE, AV_BYTES = 64 * AV_STRIDE;
constexpr int A_KOFF = 0, A_VOFF = 2 * AK_BYTES, A_WS = A_VOFF + 2 * AV_BYTES;
DI void pv_half(f32x16 (&o)[2], const f32x16& P, const char* Vb, int kvhalf, int r, int h) {
#pragma unroll
    for (int s = 0; s < 2; ++s) {
        u32x4 pa; pa.x = pk2(P[8 * s + 0], P[8 * s + 1]); pa.y = pk2(P[8 * s + 2], P[8 * s + 3]); pa.z = pk2(P[8 * s + 4], P[8 * s + 5]); pa.w = pk2(P[8 * s + 6], P[8 * s + 7]);
        const bf16x8 a = __builtin_bit_cast(bf16x8, pa);
#pragma unroll
        for (int dt = 0; dt < 2; ++dt) {
            const char* vp = Vb + (dt * 32 + r) * AV_STRIDE + (kvhalf * 32 + 16 * s + 4 * h) * 2;
            const s16x4 lo = *(const s16x4*)vp, hi = *(const s16x4*)(vp + 16);
            const bf16x8 b = __builtin_shufflevector(lo, hi, 0, 1, 2, 3, 4, 5, 6, 7);
            o[dt] = MFMA32(a, b, o[dt]);
        }
    }
}
DI void attn_unit(const bf16_t* Q, const bf16_t* K, const bf16_t* VT, bf16_t* HM, int b, int head, int qb, char* lds, const int wave_s) {
    const int tid = tid_opaque(wave_s), lane = tid & 63, wid = wave_s, r = lane & 31, h = lane >> 5;
    const int q0 = qb * 256; const size_t rowbase = (size_t)b * SEQ;
    bf16x8 qf[6];
    { const bf16_t* Qp = Q + (rowbase + q0 + wid * 32 + r) * 768 + head * 96 + 8 * h;
#pragma unroll
      for (int d0 = 0; d0 < 6; ++d0) qf[d0] = *(const bf16x8*)(Qp + 16 * d0); }
    const int NT = (q0 + 256) / 64;
    const int kr0 = tid / 12, kc0 = tid % 12, kr1 = (tid + 512) / 12, kc1 = (tid + 512) % 12;
    const bool k2 = tid < 256;
    const bf16_t* kg0 = K + (rowbase + kr0) * 768 + head * 96 + kc0 * 8;
    const bf16_t* kg1 = K + (rowbase + kr1) * 768 + head * 96 + kc1 * 8;
    const int vr = tid >> 3, vc = tid & 7;
    const bf16_t* vg = VT + ((size_t)((b * 8 + head) * 64 + vr)) * SEQ + vc * 8;
    char* kl0 = lds + A_KOFF + kr0 * AK_STRIDE + kc0 * 16; char* kl1 = lds + A_KOFF + kr1 * AK_STRIDE + kc1 * 16;
    char* vl = lds + A_VOFF + vr * AV_STRIDE + vc * 16;
    float* wsf = (float*)(lds + A_WS) + wid * 64;
    u32x4 kreg0, kreg1 = (u32x4){0u, 0u, 0u, 0u}, vreg;
    kreg0 = *(const u32x4*)kg0; if (k2) kreg1 = *(const u32x4*)kg1; vreg = *(const u32x4*)vg;
    *(u32x4*)kl0 = kreg0; if (k2) *(u32x4*)kl1 = kreg1; *(u32x2*)vl = (u32x2){vreg.x, vreg.y}; *(u32x2*)(vl + 8) = (u32x2){vreg.z, vreg.w};
    __syncthreads();
    float m_old = -INFINITY, l = 0.f; f32x16 o[2];
#pragma unroll
    for (int i = 0; i < 16; ++i) { o[0][i] = 0.f; o[1][i] = 0.f; }
    const int qg = q0 + wid * 32 + r;
    for (int t = 0; t < NT; ++t) {
        const bool more = (t + 1 < NT);
        if (more) { kreg0 = *(const u32x4*)(kg0 + (size_t)(t + 1) * 64 * 768); if (k2) kreg1 = *(const u32x4*)(kg1 + (size_t)(t + 1) * 64 * 768); vreg = *(const u32x4*)(vg + (t + 1) * 64); }
        const char* Kb = lds + A_KOFF + (t & 1) * AK_BYTES; const char* Vb = lds + A_VOFF + (t & 1) * AV_BYTES;
        f32x16 p0, p1;
#pragma unroll
        for (int i = 0; i < 16; ++i) { p0[i] = 0.f; p1[i] = 0.f; }
#pragma unroll
        for (int d0 = 0; d0 < 6; ++d0) {
            const bf16x8 a0 = *(const bf16x8*)(Kb + r * AK_STRIDE + (16 * d0 + 8 * h) * 2);
            const bf16x8 a1 = *(const bf16x8*)(Kb + (32 + r) * AK_STRIDE + (16 * d0 + 8 * h) * 2);
            p0 = MFMA32(a0, qf[d0], p0); p1 = MFMA32(a1, qf[d0], p1);
        }
        if (t >= NT - 4) {
            const int kvb = t * 64;
#pragma unroll
            for (int i = 0; i < 16; ++i) { const int kv = kvb + crow(i, h); if (kv > qg) p0[i] = -INFINITY; if (kv + 32 > qg) p1[i] = -INFINITY; }
        }
        float rm = fmaxf(p0[0], p1[0]);
#pragma unroll
        for (int i = 1; i < 16; ++i) rm = fmaxf(rm, fmaxf(p0[i], p1[i]));
        rm = fmaxf(rm, __shfl_xor(rm, 32));
        const float m_new = fmaxf(m_old, rm);
        const float alpha = __builtin_amdgcn_exp2f(m_old - m_new);
        m_old = m_new;
        float ps = 0.f;
#pragma unroll
        for (int i = 0; i < 16; ++i) { p0[i] = __builtin_amdgcn_exp2f(p0[i] - m_new); p1[i] = __builtin_amdgcn_exp2f(p1[i] - m_new); ps += p0[i] + p1[i]; }
        l = l * alpha + ps;
        if (__any(alpha != 1.f)) {
            if (h == 0) wsf[r] = alpha;
            LDSFENCE();
#pragma unroll
            for (int g = 0; g < 4; ++g) { const f32x4 f = *(const f32x4*)(wsf + 8 * g + 4 * h);
#pragma unroll
                for (int e = 0; e < 4; ++e) { o[0][4 * g + e] *= f[e]; o[1][4 * g + e] *= f[e]; } }
            LDSFENCE();
        }
        pv_half(o, p0, Vb, 0, r, h);
        pv_half(o, p1, Vb, 1, r, h);
        if (more) { char* kd0 = kl0 + ((t + 1) & 1) * AK_BYTES; char* kd1 = kl1 + ((t + 1) & 1) * AK_BYTES; char* vd = vl + ((t + 1) & 1) * AV_BYTES;
            *(u32x4*)kd0 = kreg0; if (k2) *(u32x4*)kd1 = kreg1; *(u32x2*)vd = (u32x2){vreg.x, vreg.y}; *(u32x2*)(vd + 8) = (u32x2){vreg.z, vreg.w}; }
        __syncthreads();
    }
    l += __shfl_xor(l, 32);
    if (h == 0) wsf[r] = 1.f / l;
    LDSFENCE();
    bf16_t* Op = HM + (rowbase + q0 + wid * 32) * 1024 + 512 + head * 64 + r;
#pragma unroll
    for (int g = 0; g < 4; ++g) { const f32x4 f = *(const f32x4*)(wsf + 8 * g + 4 * h);
#pragma unroll
        for (int e = 0; e < 4; ++e) { const int row = 8 * g + 4 * h + e;
            Op[(size_t)row * 1024] = f2bf(o[0][4 * g + e] * f[e]); Op[(size_t)row * 1024 + 32] = f2bf(o[1][4 * g + e] * f[e]); } }
    LDSFENCE();
    __syncthreads();
}

DI void conv8(const bf16_t* PROJ, size_t rowbase, int t, int col, const float* cw, const float* cb, float (&out)[8]) {
    float acc[8];
    { const f32x4 b0 = *(const f32x4*)(cb + col), b1 = *(const f32x4*)(cb + col + 4);
      acc[0] = b0.x; acc[1] = b0.y; acc[2] = b0.z; acc[3] = b0.w; acc[4] = b1.x; acc[5] = b1.y; acc[6] = b1.z; acc[7] = b1.w; }
#pragma unroll
    for (int k = 0; k < 4; ++k) {
        const int tt = t - 3 + k;
        if (tt >= 0) {
            const u32x4 w = *(const u32x4*)(PROJ + (rowbase + tt) * NPROJ + col);
            const f32x4 w0 = *(const f32x4*)(cw + k * 512 + col), w1 = *(const f32x4*)(cw + k * 512 + col + 4);
            acc[0] += w0.x * bflo(w.x); acc[1] += w0.y * bfhi(w.x); acc[2] += w0.z * bflo(w.y); acc[3] += w0.w * bfhi(w.y);
            acc[4] += w1.x * bflo(w.z); acc[5] += w1.y * bfhi(w.z); acc[6] += w1.z * bflo(w.w); acc[7] += w1.w * bfhi(w.w);
        }
    }
#pragma unroll
    for (int j = 0; j < 8; ++j) out[j] = acc[j] / (1.f + __expf(-acc[j]));
}
DI float log_sigmoid(float f) { return fminf(f, 0.f) - log1pf(__expf(-fabsf(f))); }
DI float scan_add(float x, int lane) {
#pragma unroll
    for (int o = 1; o < 64; o <<= 1) { const float t = __shfl_up(x, o); if (lane >= o) x += t; }
    return x;
}
DI float scan_max(float x, int lane) {
#pragma unroll
    for (int o = 1; o < 64; o <<= 1) { const float t = __shfl_up(x, o); if (lane >= o) x = fmaxf(x, t); }
    return x;
}
constexpr int ML_S64 = 72, ML_S128 = 136;
DI void mlstm_local_unit(const bf16_t* PROJ, const float* cw, const float* cb, const float* bg, float* CS, float* NLOC, float* MLOC, float* BEND, int bh, int c, char* lds, const int wave_s) {
    const int tid = tid_opaque(wave_s), lane = tid & 63, wid = wave_s, r = lane & 31, h = lane >> 5;
    const int b = bh >> 2, hd = bh & 3; const size_t rowbase = (size_t)b * SEQ; const int t0 = c * 64;
    bf16_t* KWT = (bf16_t*)lds;
    bf16_t* VTl = (bf16_t*)(lds + 64 * ML_S64 * 2);
    float* Wl = (float*)(lds + 64 * ML_S64 * 2 + 128 * ML_S64 * 2);
    if (wid == 0) {
        const bf16_t* pr = PROJ + (rowbase + t0 + lane) * NPROJ + C_G;
        const float ig = bf2f(pr[hd]) + bg[hd], fp = bf2f(pr[4 + hd]) + bg[4 + hd];
        const float bc = scan_add(log_sigmoid(fp), lane);
        const float bend = __shfl(bc, 63);
        const float a = bend - bc + ig;
        const float ml = wave_max(a);
        Wl[lane] = __expf(a - ml);
        if (lane == 0) { MLOC[bh * NCH + c] = ml; BEND[bh * NCH + c] = bend; }
    }
    __syncthreads();
    { const int row = tid >> 3, c8 = (tid & 7) * 8; float kv[8];
      conv8(PROJ, rowbase, t0 + row, 256 + 64 * hd + c8, cw, cb, kv);
      const float w = Wl[row] * 0.125f;
#pragma unroll
      for (int j = 0; j < 8; ++j) KWT[(c8 + j) * ML_S64 + row] = f2bf(kv[j] * w);
      const int e16 = (tid & 7) * 16;
      const u32x4 v0 = *(const u32x4*)(PROJ + (rowbase + t0 + row) * NPROJ + C_V + 128 * hd + e16), v1 = *(const u32x4*)(PROJ + (rowbase + t0 + row) * NPROJ + C_V + 128 * hd + e16 + 8);
      const unsigned vw[8] = {v0.x, v0.y, v0.z, v0.w, v1.x, v1.y, v1.z, v1.w};
#pragma unroll
      for (int j = 0; j < 8; ++j) { VTl[(e16 + 2 * j) * ML_S64 + row] = (bf16_t)(vw[j] & 0xffffu); VTl[(e16 + 2 * j + 1) * ML_S64 + row] = (bf16_t)(vw[j] >> 16); } }
    __syncthreads();
    { const int et = wid >> 1, dtile = wid & 1; f32x16 acc;
#pragma unroll
      for (int i = 0; i < 16; ++i) acc[i] = 0.f;
#pragma unroll
      for (int ks = 0; ks < 4; ++ks) { const bf16x8 a = *(const bf16x8*)(VTl + (32 * et + r) * ML_S64 + 16 * ks + 8 * h); const bf16x8 bb = *(const bf16x8*)(KWT + (32 * dtile + r) * ML_S64 + 16 * ks + 8 * h);
          acc = MFMA32(a, bb, acc); }
      float* Cp = CS + ((size_t)(bh * NCH + c) * 128 + 32 * et) * 64 + 32 * dtile + r;
#pragma unroll
      for (int i = 0; i < 16; ++i) Cp[(size_t)crow(i, h) * 64] = acc[i];
      if (tid < 64) { float s = 0.f;
#pragma unroll 8
          for (int l2 = 0; l2 < 64; ++l2) s += bf2f(KWT[tid * ML_S64 + l2]);
          NLOC[(size_t)(bh * NCH + c) * 64 + tid] = s; } }
    __syncthreads();
}
DI void mlstm_scan(float* CS, float* NLOC, const float* MLOC, const float* BEND, float* MPREV, int job, char* lds, const int wave_s) {
    const int tid = tid_opaque(wave_s); const int bh = job / 17, e = (job % 17) * 512 + tid;
    float* SP = (float*)lds; float* SL = SP + 128;
    if (tid == 0) { float m = 0.f;
        for (int c = 0; c < NCH; ++c) { const float bl = BEND[bh * NCH + c], ml = MLOC[bh * NCH + c]; const float mn = fmaxf(bl + m, ml);
            SP[c] = __expf(bl + m - mn); SL[c] = __expf(ml - mn); if (job % 17 == 0) MPREV[bh * NCH + c] = m; m = mn; } }
    __syncthreads();
    if (e < 8192 + 64) {
        float* p; size_t stride;
        if (e < 8192) { p = CS + (size_t)bh * NCH * 8192 + e; stride = 8192; } else { p = NLOC + (size_t)bh * NCH * 64 + (e - 8192); stride = 64; }
        float C = 0.f;
        for (int c0 = 0; c0 < NCH; c0 += 8) { float v[8];
#pragma unroll
            for (int u = 0; u < 8; ++u) v[u] = p[(size_t)(c0 + u) * stride];
#pragma unroll
            for (int u = 0; u < 8; ++u) { p[(size_t)(c0 + u) * stride] = C; C = SP[c0 + u] * C + SL[c0 + u] * v[u]; } }
    }
    __syncthreads();
}
constexpr int MO_QS = 0, MO_KS = 9216, MO_AM = 18432, MO_BM = 35840, MO_HS = 70656, MO_G = 104448;
DI void mlstm_out_unit(const bf16_t* PROJ, const float* cw, const float* cb, const float* bg, const float* hnorm, const float* CS, const float* NPREV, const float* MPREV, bf16_t* HM, int bh, int c, char* lds, const int wave_s) {
    const int tid = tid_opaque(wave_s), lane = tid & 63, wid = wave_s, r = lane & 31, h = lane >> 5;
    const int b = bh >> 2, hd = bh & 3; const size_t rowbase = (size_t)b * SEQ; const int t0 = c * 64;
    bf16_t* QS = (bf16_t*)(lds + MO_QS); bf16_t* KS = (bf16_t*)(lds + MO_KS); bf16_t* AM = (bf16_t*)(lds + MO_AM); bf16_t* BM = (bf16_t*)(lds + MO_BM);
    float* HS = (float*)(lds + MO_HS); float* G = (float*)(lds + MO_G);
    float* G_U = G, *G_VI = G + 64, *G_IW = G + 128, *G_EN = G + 192, *G_NP = G + 256, *G_DEN = G + 320;
    if (wid == 0) {
        const bf16_t* pr = PROJ + (rowbase + t0 + lane) * NPROJ + C_G;
        const float ig = bf2f(pr[hd]) + bg[hd], fp = bf2f(pr[4 + hd]) + bg[4 + hd];
        const float bc = scan_add(log_sigmoid(fp), lane);
        const float u = ig - bc;
        const float pm = scan_max(u, lane);
        const float mp = MPREV[bh * NCH + c];
        const float mx = fmaxf(pm, mp);
        G_U[lane] = u; G_VI[lane] = -mx; G_IW[lane] = __expf(mp - mx); G_EN[lane] = __expf(-(bc + mx));
    } else if (wid == 1) {
        G_NP[lane] = NPREV[(size_t)(bh * NCH + c) * 64 + lane];
    }
    __syncthreads();
    { const int row = tid >> 3, c8 = (tid & 7) * 8; float qv[8], kv[8];
      conv8(PROJ, rowbase, t0 + row, 64 * hd + c8, cw, cb, qv);
      conv8(PROJ, rowbase, t0 + row, 256 + 64 * hd + c8, cw, cb, kv);
      const float iw = G_IW[row];
      u32x4 qq, kk, qw;
      qq.x = pk2(qv[0], qv[1]); qq.y = pk2(qv[2], qv[3]); qq.z = pk2(qv[4], qv[5]); qq.w = pk2(qv[6], qv[7]);
      kk.x = pk2(kv[0] * 0.125f, kv[1] * 0.125f); kk.y = pk2(kv[2] * 0.125f, kv[3] * 0.125f); kk.z = pk2(kv[4] * 0.125f, kv[5] * 0.125f); kk.w = pk2(kv[6] * 0.125f, kv[7] * 0.125f);
      qw.x = pk2(qv[0] * iw, qv[1] * iw); qw.y = pk2(qv[2] * iw, qv[3] * iw); qw.z = pk2(qv[4] * iw, qv[5] * iw); qw.w = pk2(qv[6] * iw, qv[7] * iw);
      *(u32x4*)(QS + row * ML_S64 + c8) = qq; *(u32x4*)(KS + row * ML_S64 + c8) = kk; *(u32x4*)(AM + row * ML_S128 + 64 + c8) = qw;
      const int e16 = (tid & 7) * 16;
      const u32x4 v0 = *(const u32x4*)(PROJ + (rowbase + t0 + row) * NPROJ + C_V + 128 * hd + e16), v1 = *(const u32x4*)(PROJ + (rowbase + t0 + row) * NPROJ + C_V + 128 * hd + e16 + 8);
      const unsigned vw[8] = {v0.x, v0.y, v0.z, v0.w, v1.x, v1.y, v1.z, v1.w};
#pragma unroll
      for (int j = 0; j < 8; ++j) { BM[(e16 + 2 * j) * ML_S128 + row] = (bf16_t)(vw[j] & 0xffffu); BM[(e16 + 2 * j + 1) * ML_S128 + row] = (bf16_t)(vw[j] >> 16); }
      const int e = tid >> 2, d16 = (tid & 3) * 16;
      const float* cp = CS + ((size_t)(bh * NCH + c) * 128 + e) * 64 + d16;
      const f32x4 a0 = *(const f32x4*)cp, a1 = *(const f32x4*)(cp + 4), a2 = *(const f32x4*)(cp + 8), a3 = *(const f32x4*)(cp + 12);
      u32x4 c0, c1; c0.x = pk2(a0.x, a0.y); c0.y = pk2(a0.z, a0.w); c0.z = pk2(a1.x, a1.y); c0.w = pk2(a1.z, a1.w); c1.x = pk2(a2.x, a2.y); c1.y = pk2(a2.z, a2.w); c1.z = pk2(a3.x, a3.y); c1.w = pk2(a3.z, a3.w);
      *(u32x4*)(BM + e * ML_S128 + 64 + d16) = c0; *(u32x4*)(BM + e * ML_S128 + 64 + d16 + 8) = c1; }
    __syncthreads();
    if (wid < 4) {
        const int it = wid >> 1, jt = wid & 1; f32x16 acc;
#pragma unroll
        for (int i = 0; i < 16; ++i) acc[i] = 0.f;
        if (jt <= it) {
#pragma unroll
            for (int ks = 0; ks < 4; ++ks) { const bf16x8 a = *(const bf16x8*)(QS + (32 * it + r) * ML_S64 + 16 * ks + 8 * h); const bf16x8 bb = *(const bf16x8*)(KS + (32 * jt + r) * ML_S64 + 16 * ks + 8 * h);
                acc = MFMA32(a, bb, acc); }
        }
        const int j = 32 * jt + r; const float uj = G_U[j];
#pragma unroll
        for (int i2 = 0; i2 < 16; ++i2) { const int i = 32 * it + crow(i2, h);
            const float sv = (j <= i) ? acc[i2] * __expf(uj + G_VI[i]) : 0.f;
            AM[i * ML_S128 + j] = f2bf(sv); }
    }
    __syncthreads();
    { if (tid < 64) { float den = 0.f;
#pragma unroll 8
          for (int j = 0; j < 64; ++j) den += bf2f(AM[tid * ML_S128 + j]);
#pragma unroll 8
          for (int d = 0; d < 64; ++d) den += bf2f(AM[tid * ML_S128 + 64 + d]) * G_NP[d];
          G_DEN[tid] = 1.f / fmaxf(fabsf(den), G_EN[tid]); }
      const int it = wid >> 2, et = wid & 3; f32x16 acc;
#pragma unroll
      for (int i = 0; i < 16; ++i) acc[i] = 0.f;
#pragma unroll
      for (int ks = 0; ks < 8; ++ks) { const bf16x8 a = *(const bf16x8*)(AM + (32 * it + r) * ML_S128 + 16 * ks + 8 * h); const bf16x8 bb = *(const bf16x8*)(BM + (32 * et + r) * ML_S128 + 16 * ks + 8 * h);
          acc = MFMA32(a, bb, acc); }
#pragma unroll
      for (int i2 = 0; i2 < 16; ++i2) HS[(32 * it + crow(i2, h)) * 132 + 32 * et + r] = acc[i2]; }
    __syncthreads();
    { const int i = tid >> 3, p = tid & 7, e0 = p * 16; const float dn = G_DEN[i];
      float v[16]; float ss = 0.f;
#pragma unroll
      for (int q4 = 0; q4 < 4; ++q4) { const f32x4 x = *(const f32x4*)(HS + i * 132 + e0 + 4 * q4); v[4 * q4] = x.x * dn; v[4 * q4 + 1] = x.y * dn; v[4 * q4 + 2] = x.z * dn; v[4 * q4 + 3] = x.w * dn; }
#pragma unroll
      for (int j = 0; j < 16; ++j) ss += v[j] * v[j];
      ss += __shfl_xor(ss, 1); ss += __shfl_xor(ss, 2); ss += __shfl_xor(ss, 4);
      const float rs = rsqrtf(ss * (1.f / 128.f) + EPS);
      const size_t mrow = rowbase + t0 + i;
      const u32x4 o0 = *(const u32x4*)(PROJ + mrow * NPROJ + C_O + 128 * hd + e0), o1 = *(const u32x4*)(PROJ + mrow * NPROJ + C_O + 128 * hd + e0 + 8);
      const unsigned ow[8] = {o0.x, o0.y, o0.z, o0.w, o1.x, o1.y, o1.z, o1.w};
      unsigned res[8];
#pragma unroll
      for (int j = 0; j < 8; ++j) { const float g0 = hnorm[128 * hd + e0 + 2 * j], g1 = hnorm[128 * hd + e0 + 2 * j + 1];
          const float s0 = 1.f / (1.f + __expf(-bflo(ow[j]))), s1 = 1.f / (1.f + __expf(-bfhi(ow[j])));
          res[j] = pk2(v[2 * j] * rs * g0 * s0, v[2 * j + 1] * rs * g1 * s1); }
      bf16_t* op = HM + mrow * 1024 + 128 * hd + e0;
      *(u32x4*)op = (u32x4){res[0], res[1], res[2], res[3]}; *(u32x4*)(op + 8) = (u32x4){res[4], res[5], res[6], res[7]}; }
    __syncthreads();
}

struct Args { const float* in[18]; float* out; unsigned char* ws; int ph_lo, ph_hi; };
constexpr int PH_PER_LAYER = 11, N_PHASES = 1 + DEPTH * PH_PER_LAYER;

#define KAS __attribute__((address_space(4)))
#define KARG_P(i) (*(const float* const KAS*)(kp + 8 * (i)))
#define PH_BEGIN if (lo <= ph && ph < hi) { \
        const KAS char* kp = (const KAS char*)__builtin_amdgcn_kernarg_segment_ptr(); asm volatile("" : "+s"(kp)); \
        char* lds = (char*)lds_raw; PG8_LAS unsigned char* lds3 = (PG8_LAS unsigned char*)lds_raw; \
        const int tid = tid_opaque(wave_s); const int lane = tid & 63, wave = wave_s; \
        const int G = gridDim.x, bx = blockIdx.x; const int vcu = (G % 8 == 0) ? (bx % 8) * (G / 8) + bx / 8 : bx; \
        const int gw = vcu * NWAVES + wave, NGW = G * NWAVES; \
        unsigned char* ws = (unsigned char*)KARG_P(19); float* out = (float*)KARG_P(18); const float* x_in = KARG_P(0); \
        (void)lds; (void)lds3; (void)lane; (void)gw; (void)NGW; (void)out; (void)x_in; (void)vcu;
#define PH_END   if (ph + 1 < hi) grid.sync(); } ++ph;
#define XN_   ((bf16_t*)(ws + WS_XN))
#define CS_   ((float*)(ws + WS_CS))
#define PROJ_ ((bf16_t*)(ws + WS_PROJ))
#define QB_   ((bf16_t*)(ws + WS_Q))
#define KB_   ((bf16_t*)(ws + WS_K))
#define VT_   ((bf16_t*)(ws + WS_VT))
#define HB_   ((bf16_t*)(ws + WS_H))
#define MIX_  ((bf16_t*)(ws + WS_MIX))
#define HM_   ((bf16_t*)(ws + WS_HM))
#define YB_   ((bf16_t*)(ws + WS_Y))
#define CQN_  ((bf16_t*)(ws + WS_CQN))
#define CKVN_ ((bf16_t*)(ws + WS_CKVN))
#define COS_  ((float*)(ws + WS_COS))
#define SIN_  ((float*)(ws + WS_SIN))
#define MLOC_ ((float*)(ws + WS_MLOC))
#define BEND_ ((float*)(ws + WS_BEND))
#define MPREV_ ((float*)(ws + WS_MPREV))
#define NLOC_ ((float*)(ws + WS_NLOC))
#define WL_(off) ((const bf16_t*)(ws + WS_W + (size_t)l * W_LAYER + (off)))

template <int L> DI void layer_phases(cg::grid_group grid, const int lo, const int hi, int& ph, const int wave_s) {
    extern __shared__ __attribute__((aligned(16))) unsigned char lds_raw[];
    constexpr int l = L;
        PH_BEGIN
            pg8::Gemm g{XN_, WL_(W_IN), M, NPROJ, DM}; pg8::StaticOrder S; S.init(M, NPROJ, G, bx);
            EpiStore<0> E{PROJ_, NPROJ};
#ifndef SKIP_G1
            pg8::gemm_phase<EpiStore<0>, pg8::StaticOrder, true, true>(lds3, g, S, E, wave_s);
#endif
        PH_END
        PH_BEGIN
            prep_rows(PROJ_, KARG_P(8) + l * 256, KARG_P(10) + l * 128, COS_, SIN_, CQN_, CKVN_, KB_, gw, NGW, lane);
        PH_END
        PH_BEGIN
            { int Kq = 256; asm volatile("" : "+s"(Kq)); pg8::Gemm g{CQN_, WL_(W_UQ), M, 768, Kq}; pg8::StaticOrder S; S.init(M, 768, G, bx);
              EpiQ E{QB_, COS_, SIN_};
#ifndef SKIP_G2
              pg8::gemm_phase<EpiQ, pg8::StaticOrder, false, true>(lds3, g, S, E, wave_s);
#endif
            }
            { int Kk = 128; asm volatile("" : "+s"(Kk)); pg8::Gemm g{CKVN_, WL_(W_UKV), M, 1024, Kk}; pg8::StaticOrder S; S.init(M, 1024, G, bx);
              EpiKV E{KB_, VT_};
#ifndef SKIP_G3
              pg8::gemm_phase<EpiKV, pg8::StaticOrder, false, true>(lds3, g, S, E, wave_s);
#endif
            }
        PH_END
        PH_BEGIN
#ifndef SKIP_ATTN
            for (int p = vcu; p < 256; p += G) { const int b = p >> 7, head = (p >> 4) & 7, s = p & 15;
                attn_unit(QB_, KB_, VT_, HM_, b, head, 31 - s, lds, wave_s); attn_unit(QB_, KB_, VT_, HM_, b, head, s, lds, wave_s); }
#endif
#ifndef SKIP_ML
            for (int u = vcu; u < 8 * NCH; u += G)
                mlstm_local_unit(PROJ_, KARG_P(5) + l * 4 * 512, KARG_P(6) + l * 512, KARG_P(4) + l * 8, CS_, NLOC_, MLOC_, BEND_, u >> 7, u & 127, lds, wave_s);
#endif
        PH_END
        PH_BEGIN
#ifndef SKIP_ML
            for (int j = bx; j < 8 * 17; j += G) mlstm_scan(CS_, NLOC_, MLOC_, BEND_, MPREV_, j, lds, wave_s);
#endif
        PH_END
        PH_BEGIN
#ifndef SKIP_ML
            for (int u = vcu; u < 8 * NCH; u += G)
                mlstm_out_unit(PROJ_, KARG_P(5) + l * 4 * 512, KARG_P(6) + l * 512, KARG_P(4) + l * 8, KARG_P(7) + l * 512, CS_, NLOC_, MPREV_, HM_, u >> 7, u & 127, lds, wave_s);
#endif
        PH_END
        PH_BEGIN
            pg8::Gemm g{HM_, WL_(W_OUT), M, DM, DM}; pg8::StaticOrder S; S.init(M, DM, G, bx);
            EpiStore<0> E{MIX_, DM};
#ifndef SKIP_G4
            pg8::gemm_phase<EpiStore<0>, pg8::StaticOrder, false, true>(lds3, g, S, E, wave_s);
#endif
        PH_END
        PH_BEGIN
            row_pass(MIX_, (l == 0) ? x_in : out, KARG_P(13) + l * DM, out, KARG_P(14) + l * DM, XN_, gw, NGW, lane);
        PH_END
        PH_BEGIN
            pg8::Gemm g{XN_, WL_(W_UP), M, FF, DM}; pg8::StaticOrder S; S.init(M, FF, G, bx);
            EpiStore<2> E{HB_, FF};
#ifndef SKIP_G5
            pg8::gemm_phase<EpiStore<2>, pg8::StaticOrder, true, true>(lds3, g, S, E, wave_s);
#endif
        PH_END
        PH_BEGIN
            pg8::Gemm g{HB_, WL_(W_DOWN), M, DM, FF}; pg8::StaticOrder S; S.init(M, DM, G, bx);
            EpiStore<0> E{YB_, DM};
#ifndef SKIP_G6
            pg8::gemm_phase<EpiStore<0>, pg8::StaticOrder, false, true>(lds3, g, S, E, wave_s);
#endif
        PH_END
        PH_BEGIN
            row_pass(YB_, out, KARG_P(17) + l * DM, out, (l + 1 < DEPTH) ? KARG_P(2) + (l + 1) * DM : nullptr, XN_, gw, NGW, lane);
        PH_END
    }

__global__ void __launch_bounds__(NTHR, 2) fwd_kernel(Args args) {
    extern __shared__ __attribute__((aligned(16))) unsigned char lds_raw[];
    cg::grid_group grid = cg::this_grid();
    const int lo = args.ph_lo, hi = args.ph_hi;
    const int wave_s = __builtin_amdgcn_readfirstlane((int)threadIdx.x >> 6);
    int ph = 0;
    PH_BEGIN
        float* scr = (float*)(lds + wave * 16384);
        constexpr int I_IN = 16 * 64, I_UQ = 4 * 24, I_UKV = 2 * 32, I_OUT = 16 * 32, I_UP = 16 * 128, I_DN = 64 * 32, I_L = I_IN + I_UQ + I_UKV + I_OUT + I_UP + I_DN;
        for (int it = gw; it < DEPTH * I_L; it += NGW) {
            const int l = it / I_L; int rI = it % I_L; unsigned char* wl = ws + WS_W + (size_t)l * W_LAYER;
            if (rI < I_IN) { transpose_item(KARG_P(3) + (size_t)l * DM * INW, DM, INW, NPROJ, (bf16_t*)(wl + W_IN), scr, rI, lane); continue; } rI -= I_IN;
            if (rI < I_UQ) { transpose_item(KARG_P(9) + (size_t)l * 256 * 768, 256, 768, 768, (bf16_t*)(wl + W_UQ), scr, rI, lane); continue; } rI -= I_UQ;
            if (rI < I_UKV) { transpose_item(KARG_P(11) + (size_t)l * 128 * 1024, 128, 1024, 1024, (bf16_t*)(wl + W_UKV), scr, rI, lane); continue; } rI -= I_UKV;
            if (rI < I_OUT) { transpose_item(KARG_P(12) + (size_t)l * DM * DM, DM, DM, DM, (bf16_t*)(wl + W_OUT), scr, rI, lane); continue; } rI -= I_OUT;
            if (rI < I_UP) { transpose_item(KARG_P(15) + (size_t)l * DM * FF, DM, FF, FF, (bf16_t*)(wl + W_UP), scr, rI, lane); continue; } rI -= I_UP;
            transpose_item(KARG_P(16) + (size_t)l * FF * DM, FF, DM, DM, (bf16_t*)(wl + W_DOWN), scr, rI, lane);
        }
        rope_tables((const int*)KARG_P(1), COS_, SIN_, bx * NTHR + tid, G * NTHR);
        row_pass(nullptr, x_in, nullptr, nullptr, KARG_P(2), XN_, gw, NGW, lane);
    PH_END

    layer_phases<0>(grid, lo, hi, ph, wave_s);
    layer_phases<1>(grid, lo, hi, ph, wave_s);
#undef PH_BEGIN
#undef PH_END
}

#ifndef N_LAUNCH_MODE
#define N_LAUNCH_MODE 1
#endif
extern "C" void kernel_launch(void* const* d_in, const int* in_sizes, int n_in, void* d_out, int out_size, void* d_ws, size_t ws_size, hipStream_t stream) {
    static int grid = 0;
    if (grid == 0) {
        if (n_in != 18 || in_sizes[0] != M * DM || out_size != M * DM || ws_size < WS_END) { fprintf(stderr, "kernel_launch: unexpected shapes (n_in %d, in0 %d, out %d, ws %zu)\n", n_in, n_in > 0 ? in_sizes[0] : -1, out_size, ws_size); grid = -1; return; }
        int dev = 0, cus = 0, per_cu = 0;
        hipGetDevice(&dev); hipDeviceGetAttribute(&cus, hipDeviceAttributeMultiprocessorCount, dev);
        hipFuncSetAttribute((const void*)fwd_kernel, hipFuncAttributeMaxDynamicSharedMemorySize, LDS_BYTES);
        hipOccupancyMaxActiveBlocksPerMultiprocessor(&per_cu, (const void*)fwd_kernel, NTHR, LDS_BYTES);
        if (per_cu < 1) { fprintf(stderr, "kernel_launch: occupancy query says %d blocks per CU\n", per_cu); per_cu = 1; }
        (void)hipGetLastError();
        grid = cus;
    }
    if (grid < 0) return;
    Args a{};
    for (int i = 0; i < 18; ++i) a.in[i] = (const float*)d_in[i];
    a.out = (float*)d_out; a.ws = (unsigned char*)d_ws;
#if N_LAUNCH_MODE == 1
    a.ph_lo = 0; a.ph_hi = N_PHASES;
    void* kargs[] = {&a};
    hipError_t e = hipLaunchCooperativeKernel((const void*)fwd_kernel, dim3(grid), dim3(NTHR), kargs, LDS_BYTES, stream);
    if (e != hipSuccess) fprintf(stderr, "cooperative launch failed: %s (grid %d)\n", hipGetErrorString(e), grid);
#else
    for (int p = 0; p < N_PHASES; ++p) { a.ph_lo = p; a.ph_hi = p + 1; hipLaunchKernelGGL(fwd_kernel, dim3(grid), dim3(NTHR), LDS_BYTES, stream, a); }
#endif
}
```

```cpp
#include <hip/hip_runtime.h>
#include <hip/hip_cooperative_groups.h>
#include <cstdio>
#include <cstdint>
namespace cg = cooperative_groups;
namespace pg8 {
#define PG8_LAS __attribute__((address_space(3)))
typedef unsigned short bf16_t;
typedef short bf16x8 __attribute__((ext_vector_type(8)));
typedef float f32x4 __attribute__((ext_vector_type(4)));
typedef unsigned u32x4 __attribute__((ext_vector_type(4)));
constexpr int BM = 256, BK = 64, HALF = 128, HTB = HALF * BK * 2  , STAGE_BYTES = 8 * HTB, NXCD = 8, WGM = 8;

__host__ __device__ __forceinline__ int lds_byte(int r, int c) { const int st = (r >> 4) * 2 + (c >> 5), rr = r & 15, cc = c & 31, ob = rr * 64 + cc * 2; return st * 1024 + (ob ^ (((ob >> 9) & 1) << 5)); }
__host__ __device__ __forceinline__ void stage_rc(int b, int& R, int& C) { const int st = b / 1024, sb = b % 1024, swz = sb ^ (((sb >> 9) & 1) << 5); R = (st >> 1) * 16 + swz / 64; C = (st & 1) * 32 + (swz % 64) / 2; }
__host__ __device__ __forceinline__ int perm32(int rho) { const int n = rho >> 4, i = rho & 15; return 8 * (i >> 2) + 4 * n + (i & 3); }

struct Unit { int pm, pn; };
struct Gemm { const bf16_t* A; const bf16_t* Bt; int M, N, K; };

struct StaticOrder {
    int nM, nN, nwg, G, c;
    __host__ __device__ void init(int M, int N, int G_, int c_) { nM = M / BM; nN = N / BM; nwg = nM * nN; G = G_; c = c_; }
    __host__ __device__ bool next(int i, Unit& u) const {
        const long L = (long)i * G + c; if (L >= nwg) return false;
        int wgid = (int)L; { const int q = nwg / NXCD, r = nwg % NXCD, xcd = wgid % NXCD, off = wgid / NXCD; wgid = (xcd < r ? xcd * (q + 1) : r * (q + 1) + (xcd - r) * q) + off; }
        const int nig = WGM * nN, gid = wgid / nig, fm = gid * WGM, gsz = (nM - fm) < WGM ? (nM - fm) : WGM;
        u.pm = fm + ((wgid % nig) % gsz); u.pn = (wgid % nig) / gsz; return true;
    }
    __device__ __forceinline__ void a_ready(const Unit&) const {}
    __device__ __forceinline__ void done(const Unit&) const {}
};


__device__ __forceinline__ unsigned cvt_pk_bf16(float lo, float hi) { unsigned r; asm volatile("v_cvt_pk_bf16_f32 %0, %1, %2" : "=v"(r) : "v"(lo), "v"(hi)); return r; }

template <class Epi, class Sched, bool ALIGN_EPI = false, bool SP2 = false>
__device__ __forceinline__ void gemm_phase(PG8_LAS unsigned char* lds, const Gemm g, const Sched& S, const Epi& E, const int wave_s) {
    unsigned ones_l = ~0u; asm volatile("" : "+s"(ones_l));
    const int tid = wave_s * 64 + (int)__builtin_amdgcn_mbcnt_hi(ones_l, __builtin_amdgcn_mbcnt_lo(ones_l, 0u)), wid = __builtin_amdgcn_readfirstlane(tid >> 6), lane = tid & 63, wr = wid >> 2, wc = wid & 3, fr = lane & 15, fq = lane >> 4;
    const int K = g.K, nt = K / BK;
    unsigned voffA[2], voffB[2];
#pragma unroll
    for (int i = 0; i < 2; ++i) { int R, C; stage_rc(tid * 16 + i * 8192, R, C); const int Rb = Epi::PERM ? ((R & ~31) + perm32(R & 31)) : R;
        voffA[i] = (unsigned)(R * K + C) * 2u; voffB[i] = (unsigned)(Rb * K + C) * 2u; }
    const size_t kstep = (size_t)(BK * 2);
    const size_t hstep = (size_t)HALF * K * 2;
    const size_t tstep = 2 * hstep;
    const unsigned ldsw = (unsigned)wid * 1024u;
    const int aoff = lds_byte(wr * 64 + fr, fq * 8), boff = lds_byte(wc * 32 + fr, fq * 8);
#define PG8_SA(b, h) (((b) * 2 + (h)) * HTB)
#define PG8_SB(b, h) ((4 + (b) * 2 + (h)) * HTB)
#define PG8_STAGE(bufoff, gbase, voff) do { _Pragma("unroll") for (int _i = 0; _i < 2; ++_i) \
        __builtin_amdgcn_global_load_lds((const unsigned*)((const char*)(gbase) + (voff)[_i]), (PG8_LAS unsigned*)(lds + (bufoff) + ldsw + _i * 8192), 16, 0, 0); } while (0)
#define PG8_LDA(dst, b, h) do { _Pragma("unroll") for (int m = 0; m < 4; ++m) _Pragma("unroll") for (int k = 0; k < 2; ++k) dst[m][k] = *(const PG8_LAS bf16x8*)(lds + PG8_SA(b, h) + aoff + m * 2048 + k * 1024); } while (0)
#define PG8_LDB(dst, b, h) do { _Pragma("unroll") for (int n = 0; n < 2; ++n) _Pragma("unroll") for (int k = 0; k < 2; ++k) dst[n][k] = *(const PG8_LAS bf16x8*)(lds + PG8_SB(b, h) + boff + n * 2048 + k * 1024); } while (0)
#define PG8_MMA(ai, bj, At, Bt) do { __builtin_amdgcn_s_setprio(1); _Pragma("unroll") for (int m = 0; m < 4; ++m) _Pragma("unroll") for (int n = 0; n < 2; ++n) _Pragma("unroll") for (int k = 0; k < 2; ++k) \
        acc[ai][bj][m][n] = __builtin_amdgcn_mfma_f32_16x16x32_bf16(Bt[n][k], At[m][k], acc[ai][bj][m][n], 0, 0, 0); __builtin_amdgcn_s_setprio(0); } while (0)
#define PG8_WAIT_V(n) asm volatile("s_waitcnt vmcnt(" #n ")" ::: "memory")
#define PG8_WAIT_L(n) asm volatile("s_waitcnt lgkmcnt(" #n ")" ::: "memory")
#define PG8_BAR __builtin_amdgcn_s_barrier()
#define PG8_SCHED __builtin_amdgcn_sched_barrier(0)
    Unit cur, nxt; int ui = 0;
    if (!S.next(0, cur)) return;
    f32x4 acc[2][2][4][2];
#pragma unroll
    for (int a = 0; a < 2; ++a)
#pragma unroll
        for (int b = 0; b < 2; ++b)
#pragma unroll
            for (int m = 0; m < 4; ++m)
#pragma unroll
                for (int n = 0; n < 2; ++n) acc[a][b][m][n] = (f32x4){0.f, 0.f, 0.f, 0.f};
    bf16x8 At[4][2], B0[2][2], B1[2][2];
    const char* cA = (const char*)g.A + (size_t)cur.pm * tstep; const char* cB = (const char*)g.Bt + (size_t)cur.pn * tstep;
    S.a_ready(cur);
    if constexpr (SP2) {
        PG8_STAGE(PG8_SB(0, 0), cB, voffB); PG8_STAGE(PG8_SB(0, 1), cB + hstep, voffB); PG8_STAGE(PG8_SA(0, 0), cA, voffA); PG8_STAGE(PG8_SA(0, 1), cA + hstep, voffA);
        if (wr == 1) PG8_BAR;
        PG8_WAIT_V(2); PG8_BAR;
        PG8_STAGE(PG8_SB(1, 0), cB + kstep, voffB); PG8_STAGE(PG8_SA(1, 0), cA + kstep, voffA); PG8_STAGE(PG8_SB(1, 1), cB + hstep + kstep, voffB);
        PG8_WAIT_V(6); PG8_BAR;
    } else {
        PG8_STAGE(PG8_SB(0, 0), cB, voffB); PG8_STAGE(PG8_SA(0, 0), cA, voffA); PG8_STAGE(PG8_SB(0, 1), cB + hstep, voffB); PG8_STAGE(PG8_SA(0, 1), cA + hstep, voffA);
        if (wr == 1) PG8_BAR;
        PG8_WAIT_V(4); PG8_BAR;
        PG8_STAGE(PG8_SB(1, 0), cB + kstep, voffB); PG8_STAGE(PG8_SA(1, 0), cA + kstep, voffA); PG8_STAGE(PG8_SB(1, 1), cB + hstep + kstep, voffB);
        PG8_WAIT_V(6); PG8_BAR;
    }
    for (;;) {
        const bool has_next = S.next(ui + 1, nxt);
        const char* nA = has_next ? (const char*)g.A + (size_t)nxt.pm * tstep : cA; const char* nB = has_next ? (const char*)g.Bt + (size_t)nxt.pn * tstep : cB;
        for (int t = 0; t < nt; t += 2) {
            const bool last = (t == nt - 2);
            const char* a1 = cA + (size_t)(t + 1) * kstep;
            const char* a2 = last ? nA : cA + (size_t)(t + 2) * kstep; const char* b2 = last ? nB : cB + (size_t)(t + 2) * kstep;
            const char* a3 = a2 + kstep; const char* b3 = b2 + kstep;
            if (last && has_next) S.a_ready(nxt);
            if constexpr (SP2) {
            PG8_LDB(B0, 0, 0); PG8_LDB(B1, 0, 1); PG8_SCHED; PG8_LDA(At, 0, 0); PG8_STAGE(PG8_SA(1, 1), a1 + hstep, voffA);
            PG8_WAIT_V(8); PG8_WAIT_L(0); PG8_BAR; PG8_MMA(0, 0, At, B0); PG8_MMA(0, 1, At, B1); PG8_BAR; PG8_SCHED;
            PG8_LDA(At, 0, 1); PG8_STAGE(PG8_SB(0, 0), b2, voffB); PG8_STAGE(PG8_SB(0, 1), b2 + hstep, voffB); PG8_STAGE(PG8_SA(0, 0), a2, voffA);
            PG8_WAIT_V(8); PG8_WAIT_L(0); PG8_BAR; PG8_MMA(1, 0, At, B0); PG8_MMA(1, 1, At, B1); PG8_BAR; PG8_SCHED;
            PG8_LDB(B0, 1, 0); PG8_LDB(B1, 1, 1); PG8_SCHED; PG8_LDA(At, 1, 0); PG8_STAGE(PG8_SA(0, 1), a2 + hstep, voffA);
            PG8_WAIT_V(8); PG8_WAIT_L(0); PG8_BAR; PG8_MMA(0, 0, At, B0); PG8_MMA(0, 1, At, B1); PG8_BAR; PG8_SCHED;
            PG8_LDA(At, 1, 1); PG8_STAGE(PG8_SB(1, 0), b3, voffB); PG8_STAGE(PG8_SB(1, 1), b3 + hstep, voffB); PG8_STAGE(PG8_SA(1, 0), a3, voffA);
            PG8_WAIT_V(8); PG8_WAIT_L(0); PG8_BAR; PG8_MMA(1, 0, At, B0); PG8_MMA(1, 1, At, B1); PG8_BAR; PG8_SCHED;
            } else {
            PG8_LDB(B0, 0, 0); PG8_SCHED; PG8_LDA(At, 0, 0); PG8_STAGE(PG8_SA(1, 1), a1 + hstep, voffA);
            PG8_WAIT_L(8); PG8_BAR; PG8_WAIT_L(0); PG8_MMA(0, 0, At, B0); PG8_BAR; PG8_SCHED;
            PG8_LDB(B1, 0, 1); PG8_STAGE(PG8_SB(0, 0), b2, voffB);
            PG8_BAR; PG8_WAIT_L(0); PG8_MMA(0, 1, At, B1); PG8_BAR;
            PG8_LDA(At, 0, 1); PG8_STAGE(PG8_SA(0, 0), a2, voffA);
            PG8_BAR; PG8_WAIT_L(0); PG8_MMA(1, 0, At, B0); PG8_BAR; PG8_SCHED;
            PG8_STAGE(PG8_SB(0, 1), b2 + hstep, voffB);
            PG8_WAIT_V(6); PG8_BAR; PG8_MMA(1, 1, At, B1); PG8_BAR;
            PG8_LDB(B0, 1, 0); PG8_SCHED; PG8_LDA(At, 1, 0); PG8_STAGE(PG8_SA(0, 1), a2 + hstep, voffA);
            PG8_WAIT_L(8); PG8_BAR; PG8_WAIT_L(0); PG8_MMA(0, 0, At, B0); PG8_BAR; PG8_SCHED;
            PG8_LDB(B1, 1, 1); PG8_STAGE(PG8_SB(1, 0), b3, voffB);
            PG8_BAR; PG8_WAIT_L(0); PG8_MMA(0, 1, At, B1); PG8_BAR;
            PG8_LDA(At, 1, 1); PG8_STAGE(PG8_SA(1, 0), a3, voffA);
            PG8_BAR; PG8_WAIT_L(0); PG8_MMA(1, 0, At, B0); PG8_BAR; PG8_SCHED;
            PG8_STAGE(PG8_SB(1, 1), b3 + hstep, voffB);
            PG8_WAIT_V(6); PG8_BAR; PG8_MMA(1, 1, At, B1); PG8_BAR;
            }
        }
        if constexpr (ALIGN_EPI) { if (wr == 0) PG8_BAR; }
        if constexpr (!Epi::AFTER_DRAIN) { E(acc, cur, wr, wc, fr, fq); S.done(cur); }
        if (!has_next) break;
#pragma unroll
        for (int a = 0; a < 2; ++a)
#pragma unroll
            for (int b = 0; b < 2; ++b)
#pragma unroll
                for (int m = 0; m < 4; ++m)
#pragma unroll
                    for (int n = 0; n < 2; ++n) acc[a][b][m][n] = (f32x4){0.f, 0.f, 0.f, 0.f};
        cur = nxt; cA = nA; cB = nB; ++ui;
        if constexpr (ALIGN_EPI) { if (wr == 1) PG8_BAR; }
    }
    PG8_WAIT_V(0);
    if constexpr (!ALIGN_EPI) { if (wr == 0) PG8_BAR; }
    PG8_BAR;
    if constexpr (Epi::AFTER_DRAIN) { E.fused(acc, cur, wr, wc, fr, fq, lds, wid, lane); S.done(cur); }
#undef PG8_SA
#undef PG8_SB
#undef PG8_STAGE
#undef PG8_LDA
#undef PG8_LDB
#undef PG8_MMA
#undef PG8_WAIT_V
#undef PG8_WAIT_L
#undef PG8_BAR
#undef PG8_SCHED
}
}

#define GAS __attribute__((address_space(1)))
#define LAS __attribute__((address_space(3)))
typedef GAS unsigned gu32;
typedef GAS unsigned long long gu64;
#define RLX_AGENT __ATOMIC_RELAXED, __HIP_MEMORY_SCOPE_AGENT
#define LDS_WAIT() asm volatile("s_waitcnt lgkmcnt(0)" ::: "memory")
#define VM_WAIT() asm volatile("s_waitcnt vmcnt(0)" ::: "memory")
__device__ __forceinline__ unsigned long long rt() { return __builtin_amdgcn_s_memrealtime(); }
#define XB_TMO      128
#define XB_XCNT(j)  (256  + 64 * (j))
#define XB_XSUB(j)  (1280 + 64 * (j))
#define XB_XGEN(j)  (2304 + 64 * (j))
#define XB_TOP      3328
#define XB_TOPGEN   3392
#define XCD_BAR_WORDS 3456
#define XB_SPIN_CAP (1u << 18)

__device__ __forceinline__ unsigned xb_ld(unsigned* p)              { return __hip_atomic_load(p, __ATOMIC_RELAXED, __HIP_MEMORY_SCOPE_AGENT); }
__device__ __forceinline__ unsigned xb_add(unsigned* p, unsigned v) { return __hip_atomic_fetch_add(p, v, __ATOMIC_RELAXED, __HIP_MEMORY_SCOPE_AGENT); }
__device__ __forceinline__ unsigned xb_xcc_id() { return (unsigned)__builtin_amdgcn_s_getreg((3 << 11) | 20) & 0xFu; }
#define XB_SPIN(cond, bar) do { unsigned _sp = 0; while (cond) { __builtin_amdgcn_s_sleep(1); \
    if ((++_sp & 255u) == 0u) { if (xb_ld(&(bar)[XB_TMO])) break; if (_sp > XB_SPIN_CAP) { atomicAdd(&(bar)[XB_TMO], 1u); break; } } } } while (0)

struct XcdBarrier {
    unsigned* bar; unsigned x;
    volatile LAS unsigned* st;
};

__device__ __forceinline__ XcdBarrier xcd_barrier_post(unsigned* bar, volatile LAS unsigned* st) {
    XcdBarrier b; b.bar = bar; b.x = xb_xcc_id(); b.st = st;
    if (threadIdx.x == 0) (void)xb_add(&bar[XB_XCNT(b.x)], 1u);
    return b;
}
__device__ __forceinline__ void xcd_barrier_complete(unsigned* bar, unsigned x, unsigned& nloc, unsigned& nx) {
    const unsigned G = gridDim.x * gridDim.y * gridDim.z;
    unsigned sum, cnt, mine, sp = 0u;
    for (;;) {
        sum = 0u; cnt = 0u; mine = 0u;
#pragma unroll
        for (unsigned j = 0; j < 16; ++j) { const unsigned c = xb_ld(&bar[XB_XCNT(j)]); sum += c; cnt += (c > 0u) ? 1u : 0u; mine = (j == x) ? c : mine; }
        if (sum == G) break;
        __builtin_amdgcn_s_sleep(1);
        if ((++sp & 255u) == 0u) { if (xb_ld(&bar[XB_TMO])) break; if (sp > XB_SPIN_CAP) { atomicAdd(&bar[XB_TMO], 1u); break; } }
    }
    nloc = mine > 0u ? mine : 1u; nx = cnt > 0u ? cnt : 1u;
}

__device__ __forceinline__ void xcd_barrier(const XcdBarrier& b) {
    asm volatile("s_waitcnt vmcnt(0)" ::: "memory");
    __syncthreads();
    if (threadIdx.x == 0) {
        unsigned* bar = b.bar;
        __builtin_amdgcn_s_waitcnt(0);
        unsigned nloc = b.st[0], nx = b.st[1];
        if (nloc == 0u) { xcd_barrier_complete(bar, b.x, nloc, nx); b.st[0] = nloc; b.st[1] = nx; }
        const unsigned old = xb_add(&bar[XB_XSUB(b.x)], 1u);
        const unsigned gen = old / nloc;
        if (old + 1u == (gen + 1u) * nloc) {
            __builtin_amdgcn_fence(__ATOMIC_RELEASE, "agent");
            asm volatile("s_waitcnt vmcnt(0)" ::: "memory");
            const unsigned og = xb_add(&bar[XB_TOP], 1u);
            const unsigned tg = og / nx;
            if (og + 1u == (tg + 1u) * nx) xb_add(&bar[XB_TOPGEN], 1u);
            else XB_SPIN(xb_ld(&bar[XB_TOPGEN]) == tg, bar);
            __builtin_amdgcn_fence(__ATOMIC_ACQUIRE, "agent");
            xb_add(&bar[XB_XGEN(b.x)], 1u);
            asm volatile("s_waitcnt vmcnt(0)" ::: "memory");
        } else {
            XB_SPIN(xb_ld(&bar[XB_XGEN(b.x)]) == gen, bar);
            __builtin_amdgcn_fence(__ATOMIC_ACQUIRE, "agent");
            asm volatile("s_waitcnt vmcnt(0)" ::: "memory");
        }
    }
    __syncthreads();
}

#define DI __device__ __forceinline__
typedef unsigned short bf16_t;
typedef short bf16x8 __attribute__((ext_vector_type(8)));
typedef short s16x4 __attribute__((ext_vector_type(4)));
typedef float f32x4 __attribute__((ext_vector_type(4)));
typedef float f32x16 __attribute__((ext_vector_type(16)));
typedef unsigned u32x4 __attribute__((ext_vector_type(4)));
typedef unsigned u32x2 __attribute__((ext_vector_type(2)));

constexpr int BATCH = 2, SEQ = 8192, DM = 1024, M = BATCH * SEQ, DEPTH = 2, FF = 4096;
constexpr int NPROJ = 2048, INW = 1960;
constexpr int C_QK = 0, C_V = 512, C_O = 1024, C_G = 1536, C_CQ = 1544, C_CKV = 1800, C_KR = 1928;
constexpr int NCH = 128;
constexpr float EPS = 1e-6f;
constexpr float QSCALE = 0.10206207261596575f * 1.4426950408889634f;
constexpr int NWAVES = 8, NTHR = 512;

constexpr size_t MiB = 1u << 20;
constexpr size_t WS_MLOC = 0, WS_BEND = 4096, WS_MPREV = 8192, WS_NLOC = 65536;
constexpr size_t WS_W = 1 * MiB, W_LAYER = 23 * MiB;
constexpr size_t W_IN = 0, W_UQ = 4 * MiB, W_UKV = 4 * MiB + 512 * 1024, W_OUT = 5 * MiB, W_UP = 7 * MiB, W_DOWN = 15 * MiB;
constexpr size_t WS_COS = 47 * MiB, WS_SIN = 48 * MiB;
constexpr size_t WS_XN = 50 * MiB, WS_CS = 50 * MiB;
constexpr size_t WS_H = 82 * MiB;
constexpr size_t WS_PROJ = 82 * MiB, WS_Q = 146 * MiB, WS_K = 170 * MiB, WS_VT = 194 * MiB;
constexpr size_t WS_MIX = 82 * MiB;
constexpr size_t WS_HM = 210 * MiB, WS_Y = 210 * MiB;
constexpr size_t WS_CQN = 242 * MiB, WS_CKVN = 250 * MiB, WS_END = 254 * MiB;
constexpr size_t WS_BAR = 512 * 1024, BAR_BYTES = 16384;
constexpr int MISC_OFF = 131072 + 320;
constexpr int LDS_BYTES = 147456;
#ifndef PROBE_ATTN
#define PROBE_ATTN 0
#endif
#ifndef PROBE_ML
#define PROBE_ML 0
#endif
#ifndef PROBE_SYNC
#define PROBE_SYNC 0
#endif

DI float bf2f(bf16_t v) { return __uint_as_float((unsigned)v << 16); }
DI float bflo(unsigned w) { return __uint_as_float(w << 16); }
DI float bfhi(unsigned w) { return __uint_as_float(w & 0xffff0000u); }
typedef float f32x2_t __attribute__((ext_vector_type(2))); typedef __bf16 bf16x2_t __attribute__((ext_vector_type(2)));
DI unsigned pk2(float lo, float hi) { f32x2_t v = {lo, hi}; bf16x2_t b = __builtin_convertvector(v, bf16x2_t); return __builtin_bit_cast(unsigned, b); }
DI bf16_t f2bf(float f) { return (bf16_t)(pk2(f, 0.f) & 0xffffu); }
DI float wave_sum(float v) {
#pragma unroll
    for (int o = 1; o < 64; o <<= 1) v += __shfl_xor(v, o);
    return v;
}
DI float wave_max(float v) {
#pragma unroll
    for (int o = 1; o < 64; o <<= 1) v = fmaxf(v, __shfl_xor(v, o));
    return v;
}
DI int crow(int reg, int h) { return (reg & 3) + 8 * (reg >> 2) + 4 * h; }
DI int tid_opaque(int wave_s) { unsigned ones_l = ~0u; asm volatile("" : "+s"(ones_l)); return wave_s * 64 + (int)__builtin_amdgcn_mbcnt_hi(ones_l, __builtin_amdgcn_mbcnt_lo(ones_l, 0u)); }
#define MFMA32(a, b, c) __builtin_amdgcn_mfma_f32_32x32x16_bf16((a), (b), (c), 0, 0, 0)
#define LDSFENCE() asm volatile("s_waitcnt lgkmcnt(0)" ::: "memory")

template <int ACT  > struct EpiStore {
    static constexpr bool PERM = true, AFTER_DRAIN = false;
    bf16_t* O; int ldc;
    DI void operator()(const pg8::f32x4 (&acc)[2][2][4][2], const pg8::Unit& u, int wr, int wc, int fr, int fq) const {
#pragma unroll
        for (int ai = 0; ai < 2; ++ai)
#pragma unroll
            for (int m = 0; m < 4; ++m) {
                const int row = u.pm * 256 + ai * 128 + wr * 64 + m * 16 + fr;
#pragma unroll
                for (int bj = 0; bj < 2; ++bj) {
                    const int col0 = u.pn * 256 + bj * 128 + wc * 32 + 8 * fq;
                    pg8::f32x4 v0 = acc[ai][bj][m][0], v1 = acc[ai][bj][m][1];
                    if (ACT == 2) {
#pragma unroll
                        for (int e = 0; e < 4; ++e) { float a = fmaxf(v0[e], 0.f), b = fmaxf(v1[e], 0.f); v0[e] = a * a; v1[e] = b * b; }
                    }
                    u32x4 w; w.x = pk2(v0[0], v0[1]); w.y = pk2(v0[2], v0[3]); w.z = pk2(v1[0], v1[1]); w.w = pk2(v1[2], v1[3]);
                    *(u32x4*)(O + (size_t)row * ldc + col0) = w;
                }
            }
    }
};
struct EpiQ {
    static constexpr bool PERM = true, AFTER_DRAIN = false;
    bf16_t* Q; const float* COS; const float* SIN;
    DI void operator()(const pg8::f32x4 (&acc)[2][2][4][2], const pg8::Unit& u, int wr, int wc, int fr, int fq) const {
#pragma unroll
        for (int bj = 0; bj < 2; ++bj) {
            const int cbase = u.pn * 256 + bj * 128 + wc * 32;
            const int col0 = cbase + 8 * fq;
            const bool rope = ((cbase >> 5) % 3) == 2;
#pragma unroll
            for (int ai = 0; ai < 2; ++ai)
#pragma unroll
                for (int m = 0; m < 4; ++m) {
                    const int row = u.pm * 256 + ai * 128 + wr * 64 + m * 16 + fr;
                    pg8::f32x4 v0 = acc[ai][bj][m][0], v1 = acc[ai][bj][m][1];
                    if (rope) {
                        pg8::f32x4 o0, o1;
#pragma unroll
                        for (int e = 0; e < 4; ++e) { o0[e] = __shfl_xor(v0[e], 32); o1[e] = __shfl_xor(v1[e], 32); }
                        const int i0 = 8 * (fq & 1);
                        const pg8::f32x4 c0 = *(const pg8::f32x4*)(COS + (size_t)row * 16 + i0), c1 = *(const pg8::f32x4*)(COS + (size_t)row * 16 + i0 + 4);
                        const pg8::f32x4 s0 = *(const pg8::f32x4*)(SIN + (size_t)row * 16 + i0), s1 = *(const pg8::f32x4*)(SIN + (size_t)row * 16 + i0 + 4);
                        if (fq < 2) { v0 = v0 * c0 - o0 * s0; v1 = v1 * c1 - o1 * s1; }
                        else        { v0 = o0 * s0 + v0 * c0; v1 = o1 * s1 + v1 * c1; }
                    }
                    v0 = v0 * QSCALE; v1 = v1 * QSCALE;
                    u32x4 w; w.x = pk2(v0[0], v0[1]); w.y = pk2(v0[2], v0[3]); w.z = pk2(v1[0], v1[1]); w.w = pk2(v1[2], v1[3]);
                    *(u32x4*)(Q + (size_t)row * 768 + col0) = w;
                }
        }
    }
};
struct EpiKV {
    static constexpr bool PERM = true, AFTER_DRAIN = false;
    bf16_t* Kb; bf16_t* VT;
    DI void operator()(const pg8::f32x4 (&acc)[2][2][4][2], const pg8::Unit& u, int wr, int wc, int fr, int fq) const {
#pragma unroll
        for (int bj = 0; bj < 2; ++bj) {
            const int head = u.pn * 2 + bj, w0 = wc * 32 + 8 * fq;
#pragma unroll
            for (int ai = 0; ai < 2; ++ai)
#pragma unroll
                for (int m = 0; m < 4; ++m) {
                    const int row = u.pm * 256 + ai * 128 + wr * 64 + m * 16 + fr;
                    const pg8::f32x4 v0 = acc[ai][bj][m][0], v1 = acc[ai][bj][m][1];
                    if (wc < 2) {
                        u32x4 w; w.x = pk2(v0[0], v0[1]); w.y = pk2(v0[2], v0[3]); w.z = pk2(v1[0], v1[1]); w.w = pk2(v1[2], v1[3]);
                        *(u32x4*)(Kb + (size_t)row * 768 + head * 96 + w0) = w;
                    } else {
                        const int b = row >> 13, s = row & (SEQ - 1);
                        bf16_t* base = VT + ((size_t)((b * 8 + head) * 64 + (w0 - 64))) * SEQ + s;
#pragma unroll
                        for (int e = 0; e < 4; ++e) { base[(size_t)e * SEQ] = f2bf(v0[e]); base[(size_t)(4 + e) * SEQ] = f2bf(v1[e]); }
                    }
                }
        }
    }
};

DI void transpose_item(const float* W, int K, int N, int Npad, bf16_t* WT, float* scr, int item, int lane) {
    const int nblk = Npad / 32, kb = item / nblk, nb = item % nblk, k0 = 64 * kb, n0 = 32 * nb;
    const int n = n0 + (lane & 31);
#pragma unroll 8
    for (int i = 0; i < 32; ++i) { const int kk = 2 * i + (lane >> 5); scr[kk * 33 + (lane & 31)] = (n < N) ? W[(size_t)(k0 + kk) * N + n] : 0.f; }
    LDSFENCE();
    const int c = lane & 7;
#pragma unroll
    for (int j = 0; j < 4; ++j) { const int nn = (lane >> 3) + 8 * j; const float* s = scr + (8 * c) * 33 + nn;
        u32x4 o; o.x = pk2(s[0 * 33], s[1 * 33]); o.y = pk2(s[2 * 33], s[3 * 33]); o.z = pk2(s[4 * 33], s[5 * 33]); o.w = pk2(s[6 * 33], s[7 * 33]);
        *(u32x4*)(WT + (size_t)(n0 + nn) * K + k0 + 8 * c) = o; }
    LDSFENCE();
}
DI void row_pass(const bf16_t* src, const float* xin, const float* gpost, float* xout, const float* gnext, bf16_t* XN, int gw, int NGW, int lane) {
    for (int m = gw; m < M; m += NGW) {
        f32x4 xv[4];
#pragma unroll
        for (int j = 0; j < 4; ++j) xv[j] = *(const f32x4*)(xin + (size_t)m * DM + 4 * lane + 256 * j);
        if (src) {
            f32x4 bv[4]; float ss = 0.f;
#pragma unroll
            for (int j = 0; j < 4; ++j) { const u32x2 w = *(const u32x2*)(src + (size_t)m * DM + 4 * lane + 256 * j);
                bv[j] = (f32x4){bflo(w.x), bfhi(w.x), bflo(w.y), bfhi(w.y)}; ss += (bv[j].x * bv[j].x + bv[j].y * bv[j].y) + (bv[j].z * bv[j].z + bv[j].w * bv[j].w); }
            ss = wave_sum(ss); const float rs = rsqrtf(ss * (1.f / DM) + EPS);
#pragma unroll
            for (int j = 0; j < 4; ++j) { const f32x4 g = *(const f32x4*)(gpost + 4 * lane + 256 * j); xv[j] = xv[j] + bv[j] * rs * g;
                *(f32x4*)(xout + (size_t)m * DM + 4 * lane + 256 * j) = xv[j]; }
        }
        if (gnext) {
            float s2 = 0.f;
#pragma unroll
            for (int j = 0; j < 4; ++j) s2 += (xv[j].x * xv[j].x + xv[j].y * xv[j].y) + (xv[j].z * xv[j].z + xv[j].w * xv[j].w);
            s2 = wave_sum(s2); const float rs2 = rsqrtf(s2 * (1.f / DM) + EPS);
#pragma unroll
            for (int j = 0; j < 4; ++j) { const f32x4 g = *(const f32x4*)(gnext + 4 * lane + 256 * j); const f32x4 v = xv[j] * rs2 * g;
                u32x2 o; o.x = pk2(v.x, v.y); o.y = pk2(v.z, v.w); *(u32x2*)(XN + (size_t)m * DM + 4 * lane + 256 * j) = o; }
        }
    }
}
DI void rope_tables(const int* positions, float* COS, float* SIN, int gtid, int NT) {
    for (int idx = gtid; idx < M * 16; idx += NT) {
        const int m = idx >> 4, i = idx & 15;
        double inv = (i & 3) == 0 ? 1.0 : ((i & 3) == 1 ? 0.5623413251903491 : ((i & 3) == 2 ? 0.31622776601683794 : 0.1778279410038923));
        const int dec = i >> 2; inv *= (dec == 0 ? 1.0 : (dec == 1 ? 0.1 : (dec == 2 ? 0.01 : 0.001)));
        const float ang_f = (float)positions[m] * (float)inv;
        const double ang = (double)ang_f;
        const double k = rint(ang * 0.15915494309189535); const double rr = ang - k * 6.283185307179586;
        const double hq = rr * 0.25, x2 = hq * hq;
        const double s = hq * (1.0 - x2 / 6.0 * (1.0 - x2 / 20.0 * (1.0 - x2 / 42.0 * (1.0 - x2 / 72.0 * (1.0 - x2 / 110.0 * (1.0 - x2 / 156.0))))));
        const double c = 1.0 - x2 / 2.0 * (1.0 - x2 / 12.0 * (1.0 - x2 / 30.0 * (1.0 - x2 / 56.0 * (1.0 - x2 / 90.0 * (1.0 - x2 / 132.0)))));
        const double s2 = 2.0 * s * c, c2 = 1.0 - 2.0 * s * s; const double s4 = 2.0 * s2 * c2, c4 = 1.0 - 2.0 * s2 * s2;
        COS[idx] = (float)c4; SIN[idx] = (float)s4;
    }
}
DI void prep_rows(const bf16_t* PROJ, const float* qn, const float* kvn, const float* COS, const float* SIN, bf16_t* CQN, bf16_t* CKVN, bf16_t* Kb, int gw, int NGW, int lane) {
    for (int m = gw; m < M; m += NGW) {
        const bf16_t* pr = PROJ + (size_t)m * NPROJ;
        { const u32x2 w = *(const u32x2*)(pr + C_CQ + 4 * lane); const float c0 = bflo(w.x), c1 = bfhi(w.x), c2 = bflo(w.y), c3 = bfhi(w.y);
          const float ss = wave_sum((c0 * c0 + c1 * c1) + (c2 * c2 + c3 * c3)); const float rs = rsqrtf(ss * (1.f / 256.f) + EPS);
          const f32x4 g = *(const f32x4*)(qn + 4 * lane);
          u32x2 o; o.x = pk2(c0 * rs * g.x, c1 * rs * g.y); o.y = pk2(c2 * rs * g.z, c3 * rs * g.w); *(u32x2*)(CQN + (size_t)m * 256 + 4 * lane) = o; }
        { const unsigned w = *(const unsigned*)(pr + C_CKV + 2 * lane); const float c0 = bflo(w), c1 = bfhi(w);
          const float ss = wave_sum(c0 * c0 + c1 * c1); const float rs = rsqrtf(ss * (1.f / 128.f) + EPS);
          *(unsigned*)(CKVN + (size_t)m * 128 + 2 * lane) = pk2(c0 * rs * kvn[2 * lane], c1 * rs * kvn[2 * lane + 1]); }
        { const int i = lane & 15; const float x1 = bf2f(pr[C_KR + i]), x2 = bf2f(pr[C_KR + 16 + i]); const float c = COS[(size_t)m * 16 + i], s = SIN[(size_t)m * 16 + i];
          const float o = (lane & 16) ? (x1 * s + x2 * c) : (x1 * c - x2 * s);
          if (lane < 32) { const bf16_t ob = f2bf(o);
#pragma unroll
              for (int hh = 0; hh < 8; ++hh) Kb[(size_t)m * 768 + hh * 96 + 64 + lane] = ob; } }
    }
}

constexpr int AK_STRIDE = 208, AV_STRIDE = 136, AK_BYTES = 64 * AK_STRIDE, AV_BYTES = 64 * AV_STRIDE;
constexpr int A_KOFF = 0, A_VOFF = 2 * AK_BYTES, A_WS = A_VOFF + 2 * AV_BYTES;
DI void pv_half(f32x16 (&o)[2], const f32x16& P, const char* Vb, int kvhalf, int r, int h) {
#pragma unroll
    for (int s = 0; s < 2; ++s) {
        u32x4 pa; pa.x = pk2(P[8 * s + 0], P[8 * s + 1]); pa.y = pk2(P[8 * s + 2], P[8 * s + 3]); pa.z = pk2(P[8 * s + 4], P[8 * s + 5]); pa.w = pk2(P[8 * s + 6], P[8 * s + 7]);
        const bf16x8 a = __builtin_bit_cast(bf16x8, pa);
#pragma unroll
        for (int dt = 0; dt < 2; ++dt) {
            const char* vp = Vb + (dt * 32 + r) * AV_STRIDE + (kvhalf * 32 + 16 * s + 4 * h) * 2;
            const s16x4 lo = *(const s16x4*)vp, hi = *(const s16x4*)(vp + 16);
            const bf16x8 b = __builtin_shufflevector(lo, hi, 0, 1, 2, 3, 4, 5, 6, 7);
            o[dt] = MFMA32(a, b, o[dt]);
        }
    }
}
DI void attn_unit(const bf16_t* Q, const bf16_t* K, const bf16_t* VT, bf16_t* HM, int b, int head, int qb, char* lds, const int wave_s) {
    const int tid = tid_opaque(wave_s), lane = tid & 63, wid = wave_s, r = lane & 31, h = lane >> 5;
    const int q0 = qb * 256; const size_t rowbase = (size_t)b * SEQ;
    bf16x8 qf[6];
    { const bf16_t* Qp = Q + (rowbase + q0 + wid * 32 + r) * 768 + head * 96 + 8 * h;
#pragma unroll
      for (int d0 = 0; d0 < 6; ++d0) qf[d0] = *(const bf16x8*)(Qp + 16 * d0); }
    const int NT = (q0 + 256) / 64;
    const int kr0 = tid / 12, kc0 = tid % 12, kr1 = (tid + 512) / 12, kc1 = (tid + 512) % 12;
    const bool k2 = tid < 256;
    const bf16_t* kg0 = K + (rowbase + kr0) * 768 + head * 96 + kc0 * 8;
    const bf16_t* kg1 = K + (rowbase + kr1) * 768 + head * 96 + kc1 * 8;
    const int vr = tid >> 3, vc = tid & 7;
    const bf16_t* vg = VT + ((size_t)((b * 8 + head) * 64 + vr)) * SEQ + vc * 8;
    char* kl0 = lds + A_KOFF + kr0 * AK_STRIDE + kc0 * 16; char* kl1 = lds + A_KOFF + kr1 * AK_STRIDE + kc1 * 16;
    char* vl = lds + A_VOFF + vr * AV_STRIDE + vc * 16;
    float* wsf = (float*)(lds + A_WS) + wid * 64;
    u32x4 kreg0, kreg1 = (u32x4){0u, 0u, 0u, 0u}, vreg;
    kreg0 = *(const u32x4*)kg0; if (k2) kreg1 = *(const u32x4*)kg1; vreg = *(const u32x4*)vg;
    *(u32x4*)kl0 = kreg0; if (k2) *(u32x4*)kl1 = kreg1; *(u32x2*)vl = (u32x2){vreg.x, vreg.y}; *(u32x2*)(vl + 8) = (u32x2){vreg.z, vreg.w};
    __syncthreads();
    float m_old = -INFINITY, l = 0.f; f32x16 o[2];
#pragma unroll
    for (int i = 0; i < 16; ++i) { o[0][i] = 0.f; o[1][i] = 0.f; }
    const int qg = q0 + wid * 32 + r;
    for (int t = 0; t < NT; ++t) {
        const bool more = (t + 1 < NT);
        if (more) { kreg0 = *(const u32x4*)(kg0 + (size_t)(t + 1) * 64 * 768); if (k2) kreg1 = *(const u32x4*)(kg1 + (size_t)(t + 1) * 64 * 768); vreg = *(const u32x4*)(vg + (t + 1) * 64); }
        const char* Kb = lds + A_KOFF + (t & 1) * AK_BYTES; const char* Vb = lds + A_VOFF + (t & 1) * AV_BYTES;
        f32x16 p0, p1;
#pragma unroll
        for (int i = 0; i < 16; ++i) { p0[i] = 0.f; p1[i] = 0.f; }
#pragma unroll
        for (int d0 = 0; d0 < 6; ++d0) {
            const bf16x8 a0 = *(const bf16x8*)(Kb + r * AK_STRIDE + (16 * d0 + 8 * h) * 2);
            const bf16x8 a1 = *(const bf16x8*)(Kb + (32 + r) * AK_STRIDE + (16 * d0 + 8 * h) * 2);
            p0 = MFMA32(a0, qf[d0], p0); p1 = MFMA32(a1, qf[d0], p1);
        }
        if (t >= NT - 4) {
            const int kvb = t * 64;
#pragma unroll
            for (int i = 0; i < 16; ++i) { const int kv = kvb + crow(i, h); if (kv > qg) p0[i] = -INFINITY; if (kv + 32 > qg) p1[i] = -INFINITY; }
        }
        float rm = fmaxf(p0[0], p1[0]);
#pragma unroll
        for (int i = 1; i < 16; ++i) rm = fmaxf(rm, fmaxf(p0[i], p1[i]));
        rm = fmaxf(rm, __shfl_xor(rm, 32));
        const float m_new = fmaxf(m_old, rm);
        const float alpha = __builtin_amdgcn_exp2f(m_old - m_new);
        m_old = m_new;
        float ps = 0.f;
#pragma unroll
        for (int i = 0; i < 16; ++i) { p0[i] = __builtin_amdgcn_exp2f(p0[i] - m_new); p1[i] = __builtin_amdgcn_exp2f(p1[i] - m_new); ps += p0[i] + p1[i]; }
        l = l * alpha + ps;
        if (__any(alpha != 1.f)) {
            if (h == 0) wsf[r] = alpha;
            LDSFENCE();
#pragma unroll
            for (int g = 0; g < 4; ++g) { const f32x4 f = *(const f32x4*)(wsf + 8 * g + 4 * h);
#pragma unroll
                for (int e = 0; e < 4; ++e) { o[0][4 * g + e] *= f[e]; o[1][4 * g + e] *= f[e]; } }
            LDSFENCE();
        }
        pv_half(o, p0, Vb, 0, r, h);
        pv_half(o, p1, Vb, 1, r, h);
        if (more) { char* kd0 = kl0 + ((t + 1) & 1) * AK_BYTES; char* kd1 = kl1 + ((t + 1) & 1) * AK_BYTES; char* vd = vl + ((t + 1) & 1) * AV_BYTES;
            *(u32x4*)kd0 = kreg0; if (k2) *(u32x4*)kd1 = kreg1; *(u32x2*)vd = (u32x2){vreg.x, vreg.y}; *(u32x2*)(vd + 8) = (u32x2){vreg.z, vreg.w}; }
        __syncthreads();
    }
    l += __shfl_xor(l, 32);
    if (h == 0) wsf[r] = 1.f / l;
    LDSFENCE();
    bf16_t* Op = HM + (rowbase + q0 + wid * 32) * 1024 + 512 + head * 64 + r;
#pragma unroll
    for (int g = 0; g < 4; ++g) { const f32x4 f = *(const f32x4*)(wsf + 8 * g + 4 * h);
#pragma unroll
        for (int e = 0; e < 4; ++e) { const int row = 8 * g + 4 * h + e;
            Op[(size_t)row * 1024] = f2bf(o[0][4 * g + e] * f[e]); Op[(size_t)row * 1024 + 32] = f2bf(o[1][4 * g + e] * f[e]); } }
    LDSFENCE();
    __syncthreads();
}

DI void conv8(const bf16_t* PROJ, size_t rowbase, int t, int col, const float* cw, const float* cb, float (&out)[8]) {
    float acc[8];
    { const f32x4 b0 = *(const f32x4*)(cb + col), b1 = *(const f32x4*)(cb + col + 4);
      acc[0] = b0.x; acc[1] = b0.y; acc[2] = b0.z; acc[3] = b0.w; acc[4] = b1.x; acc[5] = b1.y; acc[6] = b1.z; acc[7] = b1.w; }
#pragma unroll
    for (int k = 0; k < 4; ++k) {
        const int tt = t - 3 + k;
        if (tt >= 0) {
            const u32x4 w = *(const u32x4*)(PROJ + (rowbase + tt) * NPROJ + col);
            const f32x4 w0 = *(const f32x4*)(cw + k * 512 + col), w1 = *(const f32x4*)(cw + k * 512 + col + 4);
            acc[0] += w0.x * bflo(w.x); acc[1] += w0.y * bfhi(w.x); acc[2] += w0.z * bflo(w.y); acc[3] += w0.w * bfhi(w.y);
            acc[4] += w1.x * bflo(w.z); acc[5] += w1.y * bfhi(w.z); acc[6] += w1.z * bflo(w.w); acc[7] += w1.w * bfhi(w.w);
        }
    }
#pragma unroll
    for (int j = 0; j < 8; ++j) out[j] = acc[j] / (1.f + __expf(-acc[j]));
}
DI float log_sigmoid(float f) { return fminf(f, 0.f) - log1pf(__expf(-fabsf(f))); }
DI float scan_add(float x, int lane) {
#pragma unroll
    for (int o = 1; o < 64; o <<= 1) { const float t = __shfl_up(x, o); if (lane >= o) x += t; }
    return x;
}
DI float scan_max(float x, int lane) {
#pragma unroll
    for (int o = 1; o < 64; o <<= 1) { const float t = __shfl_up(x, o); if (lane >= o) x = fmaxf(x, t); }
    return x;
}
constexpr int ML_S64 = 72, ML_S128 = 136;
DI void mlstm_local_unit(const bf16_t* PROJ, const float* cw, const float* cb, const float* bg, float* CS, float* NLOC, float* MLOC, float* BEND, int bh, int c, char* lds, const int wave_s) {
    const int tid = tid_opaque(wave_s), lane = tid & 63, wid = wave_s, r = lane & 31, h = lane >> 5;
    const int b = bh >> 2, hd = bh & 3; const size_t rowbase = (size_t)b * SEQ; const int t0 = c * 64;
    bf16_t* KWT = (bf16_t*)lds;
    bf16_t* VTl = (bf16_t*)(lds + 64 * ML_S64 * 2);
    float* Wl = (float*)(lds + 64 * ML_S64 * 2 + 128 * ML_S64 * 2);
    if (wid == 0) {
        const bf16_t* pr = PROJ + (rowbase + t0 + lane) * NPROJ + C_G;
        const float ig = bf2f(pr[hd]) + bg[hd], fp = bf2f(pr[4 + hd]) + bg[4 + hd];
        const float bc = scan_add(log_sigmoid(fp), lane);
        const float bend = __shfl(bc, 63);
        const float a = bend - bc + ig;
        const float ml = wave_max(a);
        Wl[lane] = __expf(a - ml);
        if (lane == 0) { MLOC[bh * NCH + c] = ml; BEND[bh * NCH + c] = bend; }
    }
    __syncthreads();
    { const int row = tid >> 3, c8 = (tid & 7) * 8; float kv[8];
      conv8(PROJ, rowbase, t0 + row, 256 + 64 * hd + c8, cw, cb, kv);
      const float w = Wl[row] * 0.125f;
#pragma unroll
      for (int j = 0; j < 8; ++j) KWT[(c8 + j) * ML_S64 + row] = f2bf(kv[j] * w);
      const int e16 = (tid & 7) * 16;
      const u32x4 v0 = *(const u32x4*)(PROJ + (rowbase + t0 + row) * NPROJ + C_V + 128 * hd + e16), v1 = *(const u32x4*)(PROJ + (rowbase + t0 + row) * NPROJ + C_V + 128 * hd + e16 + 8);
      const unsigned vw[8] = {v0.x, v0.y, v0.z, v0.w, v1.x, v1.y, v1.z, v1.w};
#pragma unroll
      for (int j = 0; j < 8; ++j) { VTl[(e16 + 2 * j) * ML_S64 + row] = (bf16_t)(vw[j] & 0xffffu); VTl[(e16 + 2 * j + 1) * ML_S64 + row] = (bf16_t)(vw[j] >> 16); } }
    __syncthreads();
    { const int et = wid >> 1, dtile = wid & 1; f32x16 acc;
#pragma unroll
      for (int i = 0; i < 16; ++i) acc[i] = 0.f;
#pragma unroll
      for (int ks = 0; ks < 4; ++ks) { const bf16x8 a = *(const bf16x8*)(VTl + (32 * et + r) * ML_S64 + 16 * ks + 8 * h); const bf16x8 bb = *(const bf16x8*)(KWT + (32 * dtile + r) * ML_S64 + 16 * ks + 8 * h);
          acc = MFMA32(a, bb, acc); }
      float* Cp = CS + ((size_t)(bh * NCH + c) * 128 + 32 * et) * 64 + 32 * dtile + r;
#pragma unroll
      for (int i = 0; i < 16; ++i) Cp[(size_t)crow(i, h) * 64] = acc[i];
      if (tid < 64) { float s = 0.f;
#pragma unroll 8
          for (int l2 = 0; l2 < 64; ++l2) s += bf2f(KWT[tid * ML_S64 + l2]);
          NLOC[(size_t)(bh * NCH + c) * 64 + tid] = s; } }
    __syncthreads();
}
DI void mlstm_scan(float* CS, float* NLOC, const float* MLOC, const float* BEND, float* MPREV, int job, char* lds, const int wave_s) {
    const int tid = tid_opaque(wave_s); const int bh = job / 17, e = (job % 17) * 512 + tid;
    float* SP = (float*)lds; float* SL = SP + 128;
    if (tid == 0) { float m = 0.f;
        for (int c = 0; c < NCH; ++c) { const float bl = BEND[bh * NCH + c], ml = MLOC[bh * NCH + c]; const float mn = fmaxf(bl + m, ml);
            SP[c] = __expf(bl + m - mn); SL[c] = __expf(ml - mn); if (job % 17 == 0) MPREV[bh * NCH + c] = m; m = mn; } }
    __syncthreads();
    if (e < 8192 + 64) {
        float* p; size_t stride;
        if (e < 8192) { p = CS + (size_t)bh * NCH * 8192 + e; stride = 8192; } else { p = NLOC + (size_t)bh * NCH * 64 + (e - 8192); stride = 64; }
        float C = 0.f;
        for (int c0 = 0; c0 < NCH; c0 += 8) { float v[8];
#pragma unroll
            for (int u = 0; u < 8; ++u) v[u] = p[(size_t)(c0 + u) * stride];
#pragma unroll
            for (int u = 0; u < 8; ++u) { p[(size_t)(c0 + u) * stride] = C; C = SP[c0 + u] * C + SL[c0 + u] * v[u]; } }
    }
    __syncthreads();
}
constexpr int MO_QS = 0, MO_KS = 9216, MO_AM = 18432, MO_BM = 35840, MO_HS = 70656, MO_G = 104448;
DI void mlstm_out_unit(const bf16_t* PROJ, const float* cw, const float* cb, const float* bg, const float* hnorm, const float* CS, const float* NPREV, const float* MPREV, bf16_t* HM, int bh, int c, char* lds, const int wave_s) {
    const int tid = tid_opaque(wave_s), lane = tid & 63, wid = wave_s, r = lane & 31, h = lane >> 5;
    const int b = bh >> 2, hd = bh & 3; const size_t rowbase = (size_t)b * SEQ; const int t0 = c * 64;
    bf16_t* QS = (bf16_t*)(lds + MO_QS); bf16_t* KS = (bf16_t*)(lds + MO_KS); bf16_t* AM = (bf16_t*)(lds + MO_AM); bf16_t* BM = (bf16_t*)(lds + MO_BM);
    float* HS = (float*)(lds + MO_HS); float* G = (float*)(lds + MO_G);
    float* G_U = G, *G_VI = G + 64, *G_IW = G + 128, *G_EN = G + 192, *G_NP = G + 256, *G_DEN = G + 320;
    if (wid == 0) {
        const bf16_t* pr = PROJ + (rowbase + t0 + lane) * NPROJ + C_G;
        const float ig = bf2f(pr[hd]) + bg[hd], fp = bf2f(pr[4 + hd]) + bg[4 + hd];
        const float bc = scan_add(log_sigmoid(fp), lane);
        const float u = ig - bc;
        const float pm = scan_max(u, lane);
        const float mp = MPREV[bh * NCH + c];
        const float mx = fmaxf(pm, mp);
        G_U[lane] = u; G_VI[lane] = -mx; G_IW[lane] = __expf(mp - mx); G_EN[lane] = __expf(-(bc + mx));
    } else if (wid == 1) {
        G_NP[lane] = NPREV[(size_t)(bh * NCH + c) * 64 + lane];
    }
    __syncthreads();
    { const int row = tid >> 3, c8 = (tid & 7) * 8; float qv[8], kv[8];
      conv8(PROJ, rowbase, t0 + row, 64 * hd + c8, cw, cb, qv);
      conv8(PROJ, rowbase, t0 + row, 256 + 64 * hd + c8, cw, cb, kv);
      const float iw = G_IW[row];
      u32x4 qq, kk, qw;
      qq.x = pk2(qv[0], qv[1]); qq.y = pk2(qv[2], qv[3]); qq.z = pk2(qv[4], qv[5]); qq.w = pk2(qv[6], qv[7]);
      kk.x = pk2(kv[0] * 0.125f, kv[1] * 0.125f); kk.y = pk2(kv[2] * 0.125f, kv[3] * 0.125f); kk.z = pk2(kv[4] * 0.125f, kv[5] * 0.125f); kk.w = pk2(kv[6] * 0.125f, kv[7] * 0.125f);
      qw.x = pk2(qv[0] * iw, qv[1] * iw); qw.y = pk2(qv[2] * iw, qv[3] * iw); qw.z = pk2(qv[4] * iw, qv[5] * iw); qw.w = pk2(qv[6] * iw, qv[7] * iw);
      *(u32x4*)(QS + row * ML_S64 + c8) = qq; *(u32x4*)(KS + row * ML_S64 + c8) = kk; *(u32x4*)(AM + row * ML_S128 + 64 + c8) = qw;
      const int e16 = (tid & 7) * 16;
      const u32x4 v0 = *(const u32x4*)(PROJ + (rowbase + t0 + row) * NPROJ + C_V + 128 * hd + e16), v1 = *(const u32x4*)(PROJ + (rowbase + t0 + row) * NPROJ + C_V + 128 * hd + e16 + 8);
      const unsigned vw[8] = {v0.x, v0.y, v0.z, v0.w, v1.x, v1.y, v1.z, v1.w};
#pragma unroll
      for (int j = 0; j < 8; ++j) { BM[(e16 + 2 * j) * ML_S128 + row] = (bf16_t)(vw[j] & 0xffffu); BM[(e16 + 2 * j + 1) * ML_S128 + row] = (bf16_t)(vw[j] >> 16); }
      const int e = tid >> 2, d16 = (tid & 3) * 16;
      const float* cp = CS + ((size_t)(bh * NCH + c) * 128 + e) * 64 + d16;
      const f32x4 a0 = *(const f32x4*)cp, a1 = *(const f32x4*)(cp + 4), a2 = *(const f32x4*)(cp + 8), a3 = *(const f32x4*)(cp + 12);
      u32x4 c0, c1; c0.x = pk2(a0.x, a0.y); c0.y = pk2(a0.z, a0.w); c0.z = pk2(a1.x, a1.y); c0.w = pk2(a1.z, a1.w); c1.x = pk2(a2.x, a2.y); c1.y = pk2(a2.z, a2.w); c1.z = pk2(a3.x, a3.y); c1.w = pk2(a3.z, a3.w);
      *(u32x4*)(BM + e * ML_S128 + 64 + d16) = c0; *(u32x4*)(BM + e * ML_S128 + 64 + d16 + 8) = c1; }
    __syncthreads();
    if (wid < 4) {
        const int it = wid >> 1, jt = wid & 1; f32x16 acc;
#pragma unroll
        for (int i = 0; i < 16; ++i) acc[i] = 0.f;
        if (jt <= it) {
#pragma unroll
            for (int ks = 0; ks < 4; ++ks) { const bf16x8 a = *(const bf16x8*)(QS + (32 * it + r) * ML_S64 + 16 * ks + 8 * h); const bf16x8 bb = *(const bf16x8*)(KS + (32 * jt + r) * ML_S64 + 16 * ks + 8 * h);
                acc = MFMA32(a, bb, acc); }
        }
        const int j = 32 * jt + r; const float uj = G_U[j];
#pragma unroll
        for (int i2 = 0; i2 < 16; ++i2) { const int i = 32 * it + crow(i2, h);
            const float sv = (j <= i) ? acc[i2] * __expf(uj + G_VI[i]) : 0.f;
            AM[i * ML_S128 + j] = f2bf(sv); }
    }
    __syncthreads();
    { if (tid < 64) { float den = 0.f;
#pragma unroll 8
          for (int j = 0; j < 64; ++j) den += bf2f(AM[tid * ML_S128 + j]);
#pragma unroll 8
          for (int d = 0; d < 64; ++d) den += bf2f(AM[tid * ML_S128 + 64 + d]) * G_NP[d];
          G_DEN[tid] = 1.f / fmaxf(fabsf(den), G_EN[tid]); }
      const int it = wid >> 2, et = wid & 3; f32x16 acc;
#pragma unroll
      for (int i = 0; i < 16; ++i) acc[i] = 0.f;
#pragma unroll
      for (int ks = 0; ks < 8; ++ks) { const bf16x8 a = *(const bf16x8*)(AM + (32 * it + r) * ML_S128 + 16 * ks + 8 * h); const bf16x8 bb = *(const bf16x8*)(BM + (32 * et + r) * ML_S128 + 16 * ks + 8 * h);
          acc = MFMA32(a, bb, acc); }
#pragma unroll
      for (int i2 = 0; i2 < 16; ++i2) HS[(32 * it + crow(i2, h)) * 132 + 32 * et + r] = acc[i2]; }
    __syncthreads();
    { const int i = tid >> 3, p = tid & 7, e0 = p * 16; const float dn = G_DEN[i];
      float v[16]; float ss = 0.f;
#pragma unroll
      for (int q4 = 0; q4 < 4; ++q4) { const f32x4 x = *(const f32x4*)(HS + i * 132 + e0 + 4 * q4); v[4 * q4] = x.x * dn; v[4 * q4 + 1] = x.y * dn; v[4 * q4 + 2] = x.z * dn; v[4 * q4 + 3] = x.w * dn; }
#pragma unroll
      for (int j = 0; j < 16; ++j) ss += v[j] * v[j];
      ss += __shfl_xor(ss, 1); ss += __shfl_xor(ss, 2); ss += __shfl_xor(ss, 4);
      const float rs = rsqrtf(ss * (1.f / 128.f) + EPS);
      const size_t mrow = rowbase + t0 + i;
      const u32x4 o0 = *(const u32x4*)(PROJ + mrow * NPROJ + C_O + 128 * hd + e0), o1 = *(const u32x4*)(PROJ + mrow * NPROJ + C_O + 128 * hd + e0 + 8);
      const unsigned ow[8] = {o0.x, o0.y, o0.z, o0.w, o1.x, o1.y, o1.z, o1.w};
      unsigned res[8];
#pragma unroll
      for (int j = 0; j < 8; ++j) { const float g0 = hnorm[128 * hd + e0 + 2 * j], g1 = hnorm[128 * hd + e0 + 2 * j + 1];
          const float s0 = 1.f / (1.f + __expf(-bflo(ow[j]))), s1 = 1.f / (1.f + __expf(-bfhi(ow[j])));
          res[j] = pk2(v[2 * j] * rs * g0 * s0, v[2 * j + 1] * rs * g1 * s1); }
      bf16_t* op = HM + mrow * 1024 + 128 * hd + e0;
      *(u32x4*)op = (u32x4){res[0], res[1], res[2], res[3]}; *(u32x4*)(op + 8) = (u32x4){res[4], res[5], res[6], res[7]}; }
    __syncthreads();
}

struct Args { const float* in[18]; float* out; unsigned char* ws; int ph_lo, ph_hi; };
constexpr int PH_PER_LAYER = 11, N_PHASES = 1 + DEPTH * PH_PER_LAYER;

#define KAS __attribute__((address_space(4)))
#define KARG_P(i) (*(const float* const KAS*)(kp + 8 * (i)))
#define PH_BEGIN if (lo <= ph && ph < hi) { \
        const KAS char* kp = (const KAS char*)__builtin_amdgcn_kernarg_segment_ptr(); asm volatile("" : "+s"(kp)); \
        char* lds = (char*)lds_raw; PG8_LAS unsigned char* lds3 = (PG8_LAS unsigned char*)lds_raw; \
        const int tid = tid_opaque(wave_s); const int lane = tid & 63, wave = wave_s; \
        const int G = gridDim.x, bx = blockIdx.x; const int vcu = (G % 8 == 0) ? (bx % 8) * (G / 8) + bx / 8 : bx; \
        const int gw = vcu * NWAVES + wave, NGW = G * NWAVES; \
        unsigned char* ws = (unsigned char*)KARG_P(19); float* out = (float*)KARG_P(18); const float* x_in = KARG_P(0); \
        (void)lds; (void)lds3; (void)lane; (void)gw; (void)NGW; (void)out; (void)x_in; (void)vcu;
#define XB_HERE() do { XcdBarrier bb_; bb_.bar = (unsigned*)(ws + WS_BAR); bb_.x = xb_xcc_id(); bb_.st = (volatile LAS unsigned*)((LAS unsigned char*)lds_raw + MISC_OFF) + 8; xcd_barrier(bb_); } while (0)
#if PROBE_SYNC
#define PH_END   if (ph + 1 < hi) { XB_HERE(); XB_HERE(); } } ++ph;
#else
#define PH_END   if (ph + 1 < hi) { XB_HERE(); } } ++ph;
#endif
#define XN_   ((bf16_t*)(ws + WS_XN))
#define CS_   ((float*)(ws + WS_CS))
#define PROJ_ ((bf16_t*)(ws + WS_PROJ))
#define QB_   ((bf16_t*)(ws + WS_Q))
#define KB_   ((bf16_t*)(ws + WS_K))
#define VT_   ((bf16_t*)(ws + WS_VT))
#define HB_   ((bf16_t*)(ws + WS_H))
#define MIX_  ((bf16_t*)(ws + WS_MIX))
#define HM_   ((bf16_t*)(ws + WS_HM))
#define YB_   ((bf16_t*)(ws + WS_Y))
#define CQN_  ((bf16_t*)(ws + WS_CQN))
#define CKVN_ ((bf16_t*)(ws + WS_CKVN))
#define COS_  ((float*)(ws + WS_COS))
#define SIN_  ((float*)(ws + WS_SIN))
#define MLOC_ ((float*)(ws + WS_MLOC))
#define BEND_ ((float*)(ws + WS_BEND))
#define MPREV_ ((float*)(ws + WS_MPREV))
#define NLOC_ ((float*)(ws + WS_NLOC))
#define WL_(off) ((const bf16_t*)(ws + WS_W + (size_t)l * W_LAYER + (off)))

template <int L> DI void layer_phases(cg::grid_group grid, const int lo, const int hi, int& ph, const int wave_s) {
    extern __shared__ __attribute__((aligned(16))) unsigned char lds_raw[];
    constexpr int l = L;
        PH_BEGIN
            pg8::Gemm g{XN_, WL_(W_IN), M, NPROJ, DM}; pg8::StaticOrder S; S.init(M, NPROJ, G, bx);
            EpiStore<0> E{PROJ_, NPROJ};
#ifndef SKIP_G1
            pg8::gemm_phase<EpiStore<0>, pg8::StaticOrder, true, true>(lds3, g, S, E, wave_s);
#endif
        PH_END
        PH_BEGIN
            prep_rows(PROJ_, KARG_P(8) + l * 256, KARG_P(10) + l * 128, COS_, SIN_, CQN_, CKVN_, KB_, gw, NGW, lane);
        PH_END
        PH_BEGIN
            { int Kq = 256; asm volatile("" : "+s"(Kq)); pg8::Gemm g{CQN_, WL_(W_UQ), M, 768, Kq}; pg8::StaticOrder S; S.init(M, 768, G, bx);
              EpiQ E{QB_, COS_, SIN_};
#ifndef SKIP_G2
              pg8::gemm_phase<EpiQ, pg8::StaticOrder, false, true>(lds3, g, S, E, wave_s);
#endif
            }
            { int Kk = 128; asm volatile("" : "+s"(Kk)); pg8::Gemm g{CKVN_, WL_(W_UKV), M, 1024, Kk}; pg8::StaticOrder S; S.init(M, 1024, G, bx);
              EpiKV E{KB_, VT_};
#ifndef SKIP_G3
              pg8::gemm_phase<EpiKV, pg8::StaticOrder, false, true>(lds3, g, S, E, wave_s);
#endif
            }
        PH_END
        PH_BEGIN
#ifndef SKIP_ATTN
            for (int rep = 0; rep < 1 + PROBE_ATTN; ++rep)
            for (int p = vcu; p < 256; p += G) { const int b = p >> 7, head = (p >> 4) & 7, s = p & 15;
                attn_unit(QB_, KB_, VT_, HM_, b, head, 31 - s, lds, wave_s); attn_unit(QB_, KB_, VT_, HM_, b, head, s, lds, wave_s); }
#endif
#ifndef SKIP_ML
            for (int rep = 0; rep < 1 + PROBE_ML; ++rep)
            for (int u = vcu; u < 8 * NCH; u += G)
                mlstm_local_unit(PROJ_, KARG_P(5) + l * 4 * 512, KARG_P(6) + l * 512, KARG_P(4) + l * 8, CS_, NLOC_, MLOC_, BEND_, u >> 7, u & 127, lds, wave_s);
#endif
        PH_END
        PH_BEGIN
#ifndef SKIP_ML
            for (int j = bx; j < 8 * 17; j += G) mlstm_scan(CS_, NLOC_, MLOC_, BEND_, MPREV_, j, lds, wave_s);
#endif
        PH_END
        PH_BEGIN
#ifndef SKIP_ML
            for (int rep = 0; rep < 1 + PROBE_ML; ++rep)
            for (int u = vcu; u < 8 * NCH; u += G)
                mlstm_out_unit(PROJ_, KARG_P(5) + l * 4 * 512, KARG_P(6) + l * 512, KARG_P(4) + l * 8, KARG_P(7) + l * 512, CS_, NLOC_, MPREV_, HM_, u >> 7, u & 127, lds, wave_s);
#endif
        PH_END
        PH_BEGIN
            pg8::Gemm g{HM_, WL_(W_OUT), M, DM, DM}; pg8::StaticOrder S; S.init(M, DM, G, bx);
            EpiStore<0> E{MIX_, DM};
#ifndef SKIP_G4
            pg8::gemm_phase<EpiStore<0>, pg8::StaticOrder, false, true>(lds3, g, S, E, wave_s);
#endif
        PH_END
        PH_BEGIN
            row_pass(MIX_, (l == 0) ? x_in : out, KARG_P(13) + l * DM, out, KARG_P(14) + l * DM, XN_, gw, NGW, lane);
        PH_END
        PH_BEGIN
            pg8::Gemm g{XN_, WL_(W_UP), M, FF, DM}; pg8::StaticOrder S; S.init(M, FF, G, bx);
            EpiStore<2> E{HB_, FF};
#ifndef SKIP_G5
            pg8::gemm_phase<EpiStore<2>, pg8::StaticOrder, true, true>(lds3, g, S, E, wave_s);
#endif
        PH_END
        PH_BEGIN
            pg8::Gemm g{HB_, WL_(W_DOWN), M, DM, FF}; pg8::StaticOrder S; S.init(M, DM, G, bx);
            EpiStore<0> E{YB_, DM};
#ifndef SKIP_G6
            pg8::gemm_phase<EpiStore<0>, pg8::StaticOrder, false, true>(lds3, g, S, E, wave_s);
#endif
        PH_END
        PH_BEGIN
            row_pass(YB_, out, KARG_P(17) + l * DM, out, (l + 1 < DEPTH) ? KARG_P(2) + (l + 1) * DM : nullptr, XN_, gw, NGW, lane);
        PH_END
    }

__global__ void __launch_bounds__(NTHR, 2) fwd_kernel(Args args) {
    extern __shared__ __attribute__((aligned(16))) unsigned char lds_raw[];
    cg::grid_group grid = cg::this_grid();
    const int lo = args.ph_lo, hi = args.ph_hi;
    const int wave_s = __builtin_amdgcn_readfirstlane((int)threadIdx.x >> 6);
    for (int u = threadIdx.x; u < (LDS_BYTES - 131072) / 4; u += NTHR) ((LAS unsigned*)((LAS unsigned char*)lds_raw + 131072))[u] = 0u;
    __syncthreads();
    (void)xcd_barrier_post((unsigned*)(args.ws + WS_BAR), (volatile LAS unsigned*)((LAS unsigned char*)lds_raw + MISC_OFF) + 8);
    if (hi < 0) grid.sync();
    int ph = 0;
    PH_BEGIN
        float* scr = (float*)(lds + wave * 16384);
        constexpr int I_IN = 16 * 64, I_UQ = 4 * 24, I_UKV = 2 * 32, I_OUT = 16 * 32, I_UP = 16 * 128, I_DN = 64 * 32, I_L = I_IN + I_UQ + I_UKV + I_OUT + I_UP + I_DN;
        for (int it = gw; it < DEPTH * I_L; it += NGW) {
            const int l = it / I_L; int rI = it % I_L; unsigned char* wl = ws + WS_W + (size_t)l * W_LAYER;
            if (rI < I_IN) { transpose_item(KARG_P(3) + (size_t)l * DM * INW, DM, INW, NPROJ, (bf16_t*)(wl + W_IN), scr, rI, lane); continue; } rI -= I_IN;
            if (rI < I_UQ) { transpose_item(KARG_P(9) + (size_t)l * 256 * 768, 256, 768, 768, (bf16_t*)(wl + W_UQ), scr, rI, lane); continue; } rI -= I_UQ;
            if (rI < I_UKV) { transpose_item(KARG_P(11) + (size_t)l * 128 * 1024, 128, 1024, 1024, (bf16_t*)(wl + W_UKV), scr, rI, lane); continue; } rI -= I_UKV;
            if (rI < I_OUT) { transpose_item(KARG_P(12) + (size_t)l * DM * DM, DM, DM, DM, (bf16_t*)(wl + W_OUT), scr, rI, lane); continue; } rI -= I_OUT;
            if (rI < I_UP) { transpose_item(KARG_P(15) + (size_t)l * DM * FF, DM, FF, FF, (bf16_t*)(wl + W_UP), scr, rI, lane); continue; } rI -= I_UP;
            transpose_item(KARG_P(16) + (size_t)l * FF * DM, FF, DM, DM, (bf16_t*)(wl + W_DOWN), scr, rI, lane);
        }
        rope_tables((const int*)KARG_P(1), COS_, SIN_, bx * NTHR + tid, G * NTHR);
        row_pass(nullptr, x_in, nullptr, nullptr, KARG_P(2), XN_, gw, NGW, lane);
    PH_END

    layer_phases<0>(grid, lo, hi, ph, wave_s);
    layer_phases<1>(grid, lo, hi, ph, wave_s);
#undef PH_BEGIN
#undef PH_END
}

#ifndef N_LAUNCH_MODE
#define N_LAUNCH_MODE 1
#endif
extern "C" void kernel_launch(void* const* d_in, const int* in_sizes, int n_in, void* d_out, int out_size, void* d_ws, size_t ws_size, hipStream_t stream) {
    static int grid = 0;
    if (grid == 0) {
        if (n_in != 18 || in_sizes[0] != M * DM || out_size != M * DM || ws_size < WS_END) { fprintf(stderr, "kernel_launch: unexpected shapes (n_in %d, in0 %d, out %d, ws %zu)\n", n_in, n_in > 0 ? in_sizes[0] : -1, out_size, ws_size); grid = -1; return; }
        int dev = 0, cus = 0, per_cu = 0;
        hipGetDevice(&dev); hipDeviceGetAttribute(&cus, hipDeviceAttributeMultiprocessorCount, dev);
        hipFuncSetAttribute((const void*)fwd_kernel, hipFuncAttributeMaxDynamicSharedMemorySize, LDS_BYTES);
        hipOccupancyMaxActiveBlocksPerMultiprocessor(&per_cu, (const void*)fwd_kernel, NTHR, LDS_BYTES);
        if (per_cu < 1) { fprintf(stderr, "kernel_launch: occupancy query says %d blocks per CU\n", per_cu); per_cu = 1; }
        (void)hipGetLastError();
        grid = cus;
    }
    if (grid < 0) return;
    Args a{};
    for (int i = 0; i < 18; ++i) a.in[i] = (const float*)d_in[i];
    a.out = (float*)d_out; a.ws = (unsigned char*)d_ws;
    (void)hipMemsetAsync((char*)d_ws + WS_BAR, 0, BAR_BYTES, stream);
#if N_LAUNCH_MODE == 1
    a.ph_lo = 0; a.ph_hi = N_PHASES;
    void* kargs[] = {&a};
    hipError_t e = hipLaunchCooperativeKernel((const void*)fwd_kernel, dim3(grid), dim3(NTHR), kargs, LDS_BYTES, stream);
    if (e != hipSuccess) fprintf(stderr, "cooperative launch failed: %s (grid %d)\n", hipGetErrorString(e), grid);
#else
    for (int p = 0; p < N_PHASES; ++p) { a.ph_lo = p; a.ph_hi = p + 1; hipLaunchKernelGGL(fwd_kernel, dim3(grid), dim3(NTHR), LDS_BYTES, stream, a); }
#endif
}
```

```cpp
#include <hip/hip_runtime.h>
#include <hip/hip_cooperative_groups.h>
#include <cstdio>
#include <cstdint>
namespace cg = cooperative_groups;
namespace pg8 {
#define PG8_LAS __attribute__((address_space(3)))
typedef unsigned short bf16_t;
typedef short bf16x8 __attribute__((ext_vector_type(8)));
typedef float f32x4 __attribute__((ext_vector_type(4)));
typedef unsigned u32x4 __attribute__((ext_vector_type(4)));
constexpr int BM = 256, BK = 64, HALF = 128, HTB = HALF * BK * 2  , STAGE_BYTES = 8 * HTB, NXCD = 8, WGM = 8;

__host__ __device__ __forceinline__ int lds_byte(int r, int c) { const int st = (r >> 4) * 2 + (c >> 5), rr = r & 15, cc = c & 31, ob = rr * 64 + cc * 2; return st * 1024 + (ob ^ (((ob >> 9) & 1) << 5)); }
__host__ __device__ __forceinline__ void stage_rc(int b, int& R, int& C) { const int st = b / 1024, sb = b % 1024, swz = sb ^ (((sb >> 9) & 1) << 5); R = (st >> 1) * 16 + swz / 64; C = (st & 1) * 32 + (swz % 64) / 2; }
__host__ __device__ __forceinline__ int perm32(int rho) { const int n = rho >> 4, i = rho & 15; return 8 * (i >> 2) + 4 * n + (i & 3); }

struct Unit { int pm, pn; };
struct Gemm { const bf16_t* A; const bf16_t* Bt; int M, N, K; };

struct StaticOrder {
    int nM, nN, nwg, G, c;
    __host__ __device__ void init(int M, int N, int G_, int c_) { nM = M / BM; nN = N / BM; nwg = nM * nN; G = G_; c = c_; }
    __host__ __device__ bool next(int i, Unit& u) const {
        const long L = (long)i * G + c; if (L >= nwg) return false;
        int wgid = (int)L; { const int q = nwg / NXCD, r = nwg % NXCD, xcd = wgid % NXCD, off = wgid / NXCD; wgid = (xcd < r ? xcd * (q + 1) : r * (q + 1) + (xcd - r) * q) + off; }
        const int nig = WGM * nN, gid = wgid / nig, fm = gid * WGM, gsz = (nM - fm) < WGM ? (nM - fm) : WGM;
        u.pm = fm + ((wgid % nig) % gsz); u.pn = (wgid % nig) / gsz; return true;
    }
    __device__ __forceinline__ void a_ready(const Unit&) const {}
    __device__ __forceinline__ void done(const Unit&) const {}
};


__device__ __forceinline__ unsigned cvt_pk_bf16(float lo, float hi) { unsigned r; asm volatile("v_cvt_pk_bf16_f32 %0, %1, %2" : "=v"(r) : "v"(lo), "v"(hi)); return r; }

template <class Epi, class Sched, bool ALIGN_EPI = false, bool SP2 = false>
__device__ __forceinline__ void gemm_phase(PG8_LAS unsigned char* lds, const Gemm g, const Sched& S, const Epi& E, const int wave_s) {
    unsigned ones_l = ~0u; asm volatile("" : "+s"(ones_l));
    const int tid = wave_s * 64 + (int)__builtin_amdgcn_mbcnt_hi(ones_l, __builtin_amdgcn_mbcnt_lo(ones_l, 0u)), wid = __builtin_amdgcn_readfirstlane(tid >> 6), lane = tid & 63, wr = wid >> 2, wc = wid & 3, fr = lane & 15, fq = lane >> 4;
    const int K = g.K, nt = K / BK;
    unsigned voffA[2], voffB[2];
#pragma unroll
    for (int i = 0; i < 2; ++i) { int R, C; stage_rc(tid * 16 + i * 8192, R, C); const int Rb = Epi::PERM ? ((R & ~31) + perm32(R & 31)) : R;
        voffA[i] = (unsigned)(R * K + C) * 2u; voffB[i] = (unsigned)(Rb * K + C) * 2u; }
    const size_t kstep = (size_t)(BK * 2);
    const size_t hstep = (size_t)HALF * K * 2;
    const size_t tstep = 2 * hstep;
    const unsigned ldsw = (unsigned)wid * 1024u;
    const int aoff = lds_byte(wr * 64 + fr, fq * 8), boff = lds_byte(wc * 32 + fr, fq * 8);
#define PG8_SA(b, h) (((b) * 2 + (h)) * HTB)
#define PG8_SB(b, h) ((4 + (b) * 2 + (h)) * HTB)
#define PG8_STAGE(bufoff, gbase, voff) do { _Pragma("unroll") for (int _i = 0; _i < 2; ++_i) \
        __builtin_amdgcn_global_load_lds((const unsigned*)((const char*)(gbase) + (voff)[_i]), (PG8_LAS unsigned*)(lds + (bufoff) + ldsw + _i * 8192), 16, 0, 0); } while (0)
#define PG8_LDA(dst, b, h) do { _Pragma("unroll") for (int m = 0; m < 4; ++m) _Pragma("unroll") for (int k = 0; k < 2; ++k) dst[m][k] = *(const PG8_LAS bf16x8*)(lds + PG8_SA(b, h) + aoff + m * 2048 + k * 1024); } while (0)
#define PG8_LDB(dst, b, h) do { _Pragma("unroll") for (int n = 0; n < 2; ++n) _Pragma("unroll") for (int k = 0; k < 2; ++k) dst[n][k] = *(const PG8_LAS bf16x8*)(lds + PG8_SB(b, h) + boff + n * 2048 + k * 1024); } while (0)
#define PG8_MMA(ai, bj, At, Bt) do { __builtin_amdgcn_s_setprio(1); _Pragma("unroll") for (int m = 0; m < 4; ++m) _Pragma("unroll") for (int n = 0; n < 2; ++n) _Pragma("unroll") for (int k = 0; k < 2; ++k) \
        acc[ai][bj][m][n] = __builtin_amdgcn_mfma_f32_16x16x32_bf16(Bt[n][k], At[m][k], acc[ai][bj][m][n], 0, 0, 0); __builtin_amdgcn_s_setprio(0); } while (0)
#define PG8_WAIT_V(n) asm volatile("s_waitcnt vmcnt(" #n ")" ::: "memory")
#define PG8_WAIT_L(n) asm volatile("s_waitcnt lgkmcnt(" #n ")" ::: "memory")
#define PG8_BAR __builtin_amdgcn_s_barrier()
#define PG8_SCHED __builtin_amdgcn_sched_barrier(0)
    Unit cur, nxt; int ui = 0;
    if (!S.next(0, cur)) return;
    f32x4 acc[2][2][4][2];
#pragma unroll
    for (int a = 0; a < 2; ++a)
#pragma unroll
        for (int b = 0; b < 2; ++b)
#pragma unroll
            for (int m = 0; m < 4; ++m)
#pragma unroll
                for (int n = 0; n < 2; ++n) acc[a][b][m][n] = (f32x4){0.f, 0.f, 0.f, 0.f};
    bf16x8 At[4][2], B0[2][2], B1[2][2];
    const char* cA = (const char*)g.A + (size_t)cur.pm * tstep; const char* cB = (const char*)g.Bt + (size_t)cur.pn * tstep;
    S.a_ready(cur);
    if constexpr (SP2) {
        PG8_STAGE(PG8_SB(0, 0), cB, voffB); PG8_STAGE(PG8_SB(0, 1), cB + hstep, voffB); PG8_STAGE(PG8_SA(0, 0), cA, voffA); PG8_STAGE(PG8_SA(0, 1), cA + hstep, voffA);
        if (wr == 1) PG8_BAR;
        PG8_WAIT_V(2); PG8_BAR;
        PG8_STAGE(PG8_SB(1, 0), cB + kstep, voffB); PG8_STAGE(PG8_SA(1, 0), cA + kstep, voffA); PG8_STAGE(PG8_SB(1, 1), cB + hstep + kstep, voffB);
        PG8_WAIT_V(6); PG8_BAR;
    } else {
        PG8_STAGE(PG8_SB(0, 0), cB, voffB); PG8_STAGE(PG8_SA(0, 0), cA, voffA); PG8_STAGE(PG8_SB(0, 1), cB + hstep, voffB); PG8_STAGE(PG8_SA(0, 1), cA + hstep, voffA);
        if (wr == 1) PG8_BAR;
        PG8_WAIT_V(4); PG8_BAR;
        PG8_STAGE(PG8_SB(1, 0), cB + kstep, voffB); PG8_STAGE(PG8_SA(1, 0), cA + kstep, voffA); PG8_STAGE(PG8_SB(1, 1), cB + hstep + kstep, voffB);
        PG8_WAIT_V(6); PG8_BAR;
    }
    for (;;) {
        const bool has_next = S.next(ui + 1, nxt);
        const char* nA = has_next ? (const char*)g.A + (size_t)nxt.pm * tstep : cA; const char* nB = has_next ? (const char*)g.Bt + (size_t)nxt.pn * tstep : cB;
        for (int t = 0; t < nt; t += 2) {
            const bool last = (t == nt - 2);
            const char* a1 = cA + (size_t)(t + 1) * kstep;
            const char* a2 = last ? nA : cA + (size_t)(t + 2) * kstep; const char* b2 = last ? nB : cB + (size_t)(t + 2) * kstep;
            const char* a3 = a2 + kstep; const char* b3 = b2 + kstep;
            if (last && has_next) S.a_ready(nxt);
            if constexpr (SP2) {
            PG8_LDB(B0, 0, 0); PG8_LDB(B1, 0, 1); PG8_SCHED; PG8_LDA(At, 0, 0); PG8_STAGE(PG8_SA(1, 1), a1 + hstep, voffA);
            PG8_WAIT_V(8); PG8_WAIT_L(0); PG8_BAR; PG8_MMA(0, 0, At, B0); PG8_MMA(0, 1, At, B1); PG8_BAR; PG8_SCHED;
            PG8_LDA(At, 0, 1); PG8_STAGE(PG8_SB(0, 0), b2, voffB); PG8_STAGE(PG8_SB(0, 1), b2 + hstep, voffB); PG8_STAGE(PG8_SA(0, 0), a2, voffA);
            PG8_WAIT_V(8); PG8_WAIT_L(0); PG8_BAR; PG8_MMA(1, 0, At, B0); PG8_MMA(1, 1, At, B1); PG8_BAR; PG8_SCHED;
            PG8_LDB(B0, 1, 0); PG8_LDB(B1, 1, 1); PG8_SCHED; PG8_LDA(At, 1, 0); PG8_STAGE(PG8_SA(0, 1), a2 + hstep, voffA);
            PG8_WAIT_V(8); PG8_WAIT_L(0); PG8_BAR; PG8_MMA(0, 0, At, B0); PG8_MMA(0, 1, At, B1); PG8_BAR; PG8_SCHED;
            PG8_LDA(At, 1, 1); PG8_STAGE(PG8_SB(1, 0), b3, voffB); PG8_STAGE(PG8_SB(1, 1), b3 + hstep, voffB); PG8_STAGE(PG8_SA(1, 0), a3, voffA);
            PG8_WAIT_V(8); PG8_WAIT_L(0); PG8_BAR; PG8_MMA(1, 0, At, B0); PG8_MMA(1, 1, At, B1); PG8_BAR; PG8_SCHED;
            } else {
            PG8_LDB(B0, 0, 0); PG8_SCHED; PG8_LDA(At, 0, 0); PG8_STAGE(PG8_SA(1, 1), a1 + hstep, voffA);
            PG8_WAIT_L(8); PG8_BAR; PG8_WAIT_L(0); PG8_MMA(0, 0, At, B0); PG8_BAR; PG8_SCHED;
            PG8_LDB(B1, 0, 1); PG8_STAGE(PG8_SB(0, 0), b2, voffB);
            PG8_BAR; PG8_WAIT_L(0); PG8_MMA(0, 1, At, B1); PG8_BAR;
            PG8_LDA(At, 0, 1); PG8_STAGE(PG8_SA(0, 0), a2, voffA);
            PG8_BAR; PG8_WAIT_L(0); PG8_MMA(1, 0, At, B0); PG8_BAR; PG8_SCHED;
            PG8_STAGE(PG8_SB(0, 1), b2 + hstep, voffB);
            PG8_WAIT_V(6); PG8_BAR; PG8_MMA(1, 1, At, B1); PG8_BAR;
            PG8_LDB(B0, 1, 0); PG8_SCHED; PG8_LDA(At, 1, 0); PG8_STAGE(PG8_SA(0, 1), a2 + hstep, voffA);
            PG8_WAIT_L(8); PG8_BAR; PG8_WAIT_L(0); PG8_MMA(0, 0, At, B0); PG8_BAR; PG8_SCHED;
            PG8_LDB(B1, 1, 1); PG8_STAGE(PG8_SB(1, 0), b3, voffB);
            PG8_BAR; PG8_WAIT_L(0); PG8_MMA(0, 1, At, B1); PG8_BAR;
            PG8_LDA(At, 1, 1); PG8_STAGE(PG8_SA(1, 0), a3, voffA);
            PG8_BAR; PG8_WAIT_L(0); PG8_MMA(1, 0, At, B0); PG8_BAR; PG8_SCHED;
            PG8_STAGE(PG8_SB(1, 1), b3 + hstep, voffB);
            PG8_WAIT_V(6); PG8_BAR; PG8_MMA(1, 1, At, B1); PG8_BAR;
            }
        }
        if constexpr (ALIGN_EPI) { if (wr == 0) PG8_BAR; }
        if constexpr (!Epi::AFTER_DRAIN) { E(acc, cur, wr, wc, fr, fq); S.done(cur); }
        if (!has_next) break;
#pragma unroll
        for (int a = 0; a < 2; ++a)
#pragma unroll
            for (int b = 0; b < 2; ++b)
#pragma unroll
                for (int m = 0; m < 4; ++m)
#pragma unroll
                    for (int n = 0; n < 2; ++n) acc[a][b][m][n] = (f32x4){0.f, 0.f, 0.f, 0.f};
        cur = nxt; cA = nA; cB = nB; ++ui;
        if constexpr (ALIGN_EPI) { if (wr == 1) PG8_BAR; }
    }
    PG8_WAIT_V(0);
    if constexpr (!ALIGN_EPI) { if (wr == 0) PG8_BAR; }
    PG8_BAR;
    if constexpr (Epi::AFTER_DRAIN) { E.fused(acc, cur, wr, wc, fr, fq, lds, wid, lane); S.done(cur); }
#undef PG8_SA
#undef PG8_SB
#undef PG8_STAGE
#undef PG8_LDA
#undef PG8_LDB
#undef PG8_MMA
#undef PG8_WAIT_V
#undef PG8_WAIT_L
#undef PG8_BAR
#undef PG8_SCHED
}
}

#define GAS __attribute__((address_space(1)))
#define LAS __attribute__((address_space(3)))
typedef GAS unsigned gu32;
typedef GAS unsigned long long gu64;
#define RLX_AGENT __ATOMIC_RELAXED, __HIP_MEMORY_SCOPE_AGENT
#define LDS_WAIT() asm volatile("s_waitcnt lgkmcnt(0)" ::: "memory")
#define VM_WAIT() asm volatile("s_waitcnt vmcnt(0)" ::: "memory")
__device__ __forceinline__ unsigned long long rt() { return __builtin_amdgcn_s_memrealtime(); }
#define XB_TMO      128
#define XB_XCNT(j)  (256  + 64 * (j))
#define XB_XSUB(j)  (1280 + 64 * (j))
#define XB_XGEN(j)  (2304 + 64 * (j))
#define XB_TOP      3328
#define XB_TOPGEN   3392
#define XCD_BAR_WORDS 3456
#define XB_SPIN_CAP (1u << 18)

__device__ __forceinline__ unsigned xb_ld(unsigned* p)              { return __hip_atomic_load(p, __ATOMIC_RELAXED, __HIP_MEMORY_SCOPE_AGENT); }
__device__ __forceinline__ unsigned xb_add(unsigned* p, unsigned v) { return __hip_atomic_fetch_add(p, v, __ATOMIC_RELAXED, __HIP_MEMORY_SCOPE_AGENT); }
__device__ __forceinline__ unsigned xb_xcc_id() { return (unsigned)__builtin_amdgcn_s_getreg((3 << 11) | 20) & 0xFu; }
#define XB_SPIN(cond, bar) do { unsigned _sp = 0; while (cond) { __builtin_amdgcn_s_sleep(1); \
    if ((++_sp & 255u) == 0u) { if (xb_ld(&(bar)[XB_TMO])) break; if (_sp > XB_SPIN_CAP) { atomicAdd(&(bar)[XB_TMO], 1u); break; } } } } while (0)

struct XcdBarrier {
    unsigned* bar; unsigned x;
    volatile LAS unsigned* st;
};

__device__ __forceinline__ XcdBarrier xcd_barrier_post(unsigned* bar, volatile LAS unsigned* st) {
    XcdBarrier b; b.bar = bar; b.x = xb_xcc_id(); b.st = st;
    if (threadIdx.x == 0) (void)xb_add(&bar[XB_XCNT(b.x)], 1u);
    return b;
}
__device__ __forceinline__ void xcd_barrier_complete(unsigned* bar, unsigned x, unsigned& nloc, unsigned& nx) {
    const unsigned G = gridDim.x * gridDim.y * gridDim.z;
    unsigned sum, cnt, mine, sp = 0u;
    for (;;) {
        sum = 0u; cnt = 0u; mine = 0u;
#pragma unroll
        for (unsigned j = 0; j < 16; ++j) { const unsigned c = xb_ld(&bar[XB_XCNT(j)]); sum += c; cnt += (c > 0u) ? 1u : 0u; mine = (j == x) ? c : mine; }
        if (sum == G) break;
        __builtin_amdgcn_s_sleep(1);
        if ((++sp & 255u) == 0u) { if (xb_ld(&bar[XB_TMO])) break; if (sp > XB_SPIN_CAP) { atomicAdd(&bar[XB_TMO], 1u); break; } }
    }
    nloc = mine > 0u ? mine : 1u; nx = cnt > 0u ? cnt : 1u;
}

__device__ __forceinline__ void xcd_barrier(const XcdBarrier& b) {
    asm volatile("s_waitcnt vmcnt(0)" ::: "memory");
    __syncthreads();
    if (threadIdx.x == 0) {
        unsigned* bar = b.bar;
        __builtin_amdgcn_s_waitcnt(0);
        unsigned nloc = b.st[0], nx = b.st[1];
        if (nloc == 0u) { xcd_barrier_complete(bar, b.x, nloc, nx); b.st[0] = nloc; b.st[1] = nx; }
        const unsigned old = xb_add(&bar[XB_XSUB(b.x)], 1u);
        const unsigned gen = old / nloc;
        if (old + 1u == (gen + 1u) * nloc) {
            __builtin_amdgcn_fence(__ATOMIC_RELEASE, "agent");
            asm volatile("s_waitcnt vmcnt(0)" ::: "memory");
            const unsigned og = xb_add(&bar[XB_TOP], 1u);
            const unsigned tg = og / nx;
            if (og + 1u == (tg + 1u) * nx) xb_add(&bar[XB_TOPGEN], 1u);
            else XB_SPIN(xb_ld(&bar[XB_TOPGEN]) == tg, bar);
            __builtin_amdgcn_fence(__ATOMIC_ACQUIRE, "agent");
            xb_add(&bar[XB_XGEN(b.x)], 1u);
            asm volatile("s_waitcnt vmcnt(0)" ::: "memory");
        } else {
            XB_SPIN(xb_ld(&bar[XB_XGEN(b.x)]) == gen, bar);
            __builtin_amdgcn_fence(__ATOMIC_ACQUIRE, "agent");
            asm volatile("s_waitcnt vmcnt(0)" ::: "memory");
        }
    }
    __syncthreads();
}

#define DI __device__ __forceinline__
typedef unsigned short bf16_t;
typedef short bf16x8 __attribute__((ext_vector_type(8)));
typedef short s16x4 __attribute__((ext_vector_type(4)));
typedef float f32x4 __attribute__((ext_vector_type(4)));
typedef float f32x16 __attribute__((ext_vector_type(16)));
typedef unsigned u32x4 __attribute__((ext_vector_type(4)));
typedef unsigned u32x2 __attribute__((ext_vector_type(2)));

constexpr int BATCH = 2, SEQ = 8192, DM = 1024, M = BATCH * SEQ, DEPTH = 2, FF = 4096;
constexpr int NPROJ = 2048, INW = 1960;
constexpr int C_QK = 0, C_V = 512, C_O = 1024, C_G = 1536, C_CQ = 1544, C_CKV = 1800, C_KR = 1928;
constexpr int NCH = 128;
constexpr float EPS = 1e-6f;
constexpr float QSCALE = 0.10206207261596575f * 1.4426950408889634f;
constexpr int NWAVES = 8, NTHR = 512;

constexpr size_t MiB = 1u << 20;
constexpr size_t WS_MLOC = 0, WS_BEND = 4096, WS_MPREV = 8192, WS_NLOC = 65536;
constexpr size_t WS_W = 1 * MiB, W_LAYER = 23 * MiB;
constexpr size_t W_IN = 0, W_UQ = 4 * MiB, W_UKV = 4 * MiB + 512 * 1024, W_OUT = 5 * MiB, W_UP = 7 * MiB, W_DOWN = 15 * MiB;
constexpr size_t WS_COS = 47 * MiB, WS_SIN = 48 * MiB;
constexpr size_t WS_XN = 50 * MiB, WS_CS = 50 * MiB;
constexpr size_t WS_H = 82 * MiB;
constexpr size_t WS_PROJ = 82 * MiB, WS_Q = 146 * MiB, WS_K = 170 * MiB, WS_VT = 194 * MiB;
constexpr size_t WS_MIX = 82 * MiB;
constexpr size_t WS_HM = 210 * MiB, WS_Y = 210 * MiB;
constexpr size_t WS_CQN = 242 * MiB, WS_CKVN = 250 * MiB, WS_END = 254 * MiB;
constexpr size_t WS_BAR = 512 * 1024, BAR_BYTES = 16384;
constexpr int MISC_OFF = 131072 + 320;
constexpr int LDS_BYTES = 147456;
#ifndef ATTN_FN
#define ATTN_FN attn_unit2
#endif
#ifndef PROBE_GEMM
#define PROBE_GEMM 0
#endif
#ifndef PROBE_ROW
#define PROBE_ROW 0
#endif
#ifndef PROBE_PRO
#define PROBE_PRO 0
#endif
#ifndef PROBE_ATTN
#define PROBE_ATTN 0
#endif
#ifndef PROBE_ML
#define PROBE_ML 0
#endif
#ifndef PROBE_SYNC
#define PROBE_SYNC 0
#endif

DI float bf2f(bf16_t v) { return __uint_as_float((unsigned)v << 16); }
DI float bflo(unsigned w) { return __uint_as_float(w << 16); }
DI float bfhi(unsigned w) { return __uint_as_float(w & 0xffff0000u); }
typedef float f32x2_t __attribute__((ext_vector_type(2))); typedef __bf16 bf16x2_t __attribute__((ext_vector_type(2)));
DI unsigned pk2(float lo, float hi) { f32x2_t v = {lo, hi}; bf16x2_t b = __builtin_convertvector(v, bf16x2_t); return __builtin_bit_cast(unsigned, b); }
DI bf16_t f2bf(float f) { return (bf16_t)(pk2(f, 0.f) & 0xffffu); }
DI float wave_sum(float v) {
#pragma unroll
    for (int o = 1; o < 64; o <<= 1) v += __shfl_xor(v, o);
    return v;
}
DI float wave_max(float v) {
#pragma unroll
    for (int o = 1; o < 64; o <<= 1) v = fmaxf(v, __shfl_xor(v, o));
    return v;
}
DI int crow(int reg, int h) { return (reg & 3) + 8 * (reg >> 2) + 4 * h; }
DI int tid_opaque(int wave_s) { unsigned ones_l = ~0u; asm volatile("" : "+s"(ones_l)); return wave_s * 64 + (int)__builtin_amdgcn_mbcnt_hi(ones_l, __builtin_amdgcn_mbcnt_lo(ones_l, 0u)); }
#define MFMA32(a, b, c) __builtin_amdgcn_mfma_f32_32x32x16_bf16((a), (b), (c), 0, 0, 0)
#define LDSFENCE() asm volatile("s_waitcnt lgkmcnt(0)" ::: "memory")

template <int ACT  > struct EpiStore {
    static constexpr bool PERM = true, AFTER_DRAIN = false;
    bf16_t* O; int ldc;
    DI void operator()(const pg8::f32x4 (&acc)[2][2][4][2], const pg8::Unit& u, int wr, int wc, int fr, int fq) const {
#pragma unroll
        for (int ai = 0; ai < 2; ++ai)
#pragma unroll
            for (int m = 0; m < 4; ++m) {
                const int row = u.pm * 256 + ai * 128 + wr * 64 + m * 16 + fr;
#pragma unroll
                for (int bj = 0; bj < 2; ++bj) {
                    const int col0 = u.pn * 256 + bj * 128 + wc * 32 + 8 * fq;
                    pg8::f32x4 v0 = acc[ai][bj][m][0], v1 = acc[ai][bj][m][1];
                    if (ACT == 2) {
#pragma unroll
                        for (int e = 0; e < 4; ++e) { float a = fmaxf(v0[e], 0.f), b = fmaxf(v1[e], 0.f); v0[e] = a * a; v1[e] = b * b; }
                    }
                    u32x4 w; w.x = pk2(v0[0], v0[1]); w.y = pk2(v0[2], v0[3]); w.z = pk2(v1[0], v1[1]); w.w = pk2(v1[2], v1[3]);
                    *(u32x4*)(O + (size_t)row * ldc + col0) = w;
                }
            }
    }
};
struct EpiQ {
    static constexpr bool PERM = true, AFTER_DRAIN = false;
    bf16_t* Q; const float* COS; const float* SIN;
    DI void operator()(const pg8::f32x4 (&acc)[2][2][4][2], const pg8::Unit& u, int wr, int wc, int fr, int fq) const {
#pragma unroll
        for (int bj = 0; bj < 2; ++bj) {
            const int cbase = u.pn * 256 + bj * 128 + wc * 32;
            const int col0 = cbase + 8 * fq;
            const bool rope = ((cbase >> 5) % 3) == 2;
#pragma unroll
            for (int ai = 0; ai < 2; ++ai)
#pragma unroll
                for (int m = 0; m < 4; ++m) {
                    const int row = u.pm * 256 + ai * 128 + wr * 64 + m * 16 + fr;
                    pg8::f32x4 v0 = acc[ai][bj][m][0], v1 = acc[ai][bj][m][1];
                    if (rope) {
                        pg8::f32x4 o0, o1;
#pragma unroll
                        for (int e = 0; e < 4; ++e) { o0[e] = __shfl_xor(v0[e], 32); o1[e] = __shfl_xor(v1[e], 32); }
                        const int i0 = 8 * (fq & 1);
                        const pg8::f32x4 c0 = *(const pg8::f32x4*)(COS + (size_t)row * 16 + i0), c1 = *(const pg8::f32x4*)(COS + (size_t)row * 16 + i0 + 4);
                        const pg8::f32x4 s0 = *(const pg8::f32x4*)(SIN + (size_t)row * 16 + i0), s1 = *(const pg8::f32x4*)(SIN + (size_t)row * 16 + i0 + 4);
                        if (fq < 2) { v0 = v0 * c0 - o0 * s0; v1 = v1 * c1 - o1 * s1; }
                        else        { v0 = o0 * s0 + v0 * c0; v1 = o1 * s1 + v1 * c1; }
                    }
                    v0 = v0 * QSCALE; v1 = v1 * QSCALE;
                    u32x4 w; w.x = pk2(v0[0], v0[1]); w.y = pk2(v0[2], v0[3]); w.z = pk2(v1[0], v1[1]); w.w = pk2(v1[2], v1[3]);
                    *(u32x4*)(Q + (size_t)row * 768 + col0) = w;
                }
        }
    }
};
struct EpiKV {
    static constexpr bool PERM = true, AFTER_DRAIN = false;
    bf16_t* Kb; bf16_t* VT;
    DI void operator()(const pg8::f32x4 (&acc)[2][2][4][2], const pg8::Unit& u, int wr, int wc, int fr, int fq) const {
#pragma unroll
        for (int bj = 0; bj < 2; ++bj) {
            const int head = u.pn * 2 + bj, w0 = wc * 32 + 8 * fq;
#pragma unroll
            for (int ai = 0; ai < 2; ++ai)
#pragma unroll
                for (int m = 0; m < 4; ++m) {
                    const int row = u.pm * 256 + ai * 128 + wr * 64 + m * 16 + fr;
                    const pg8::f32x4 v0 = acc[ai][bj][m][0], v1 = acc[ai][bj][m][1];
                    if (wc < 2) {
                        u32x4 w; w.x = pk2(v0[0], v0[1]); w.y = pk2(v0[2], v0[3]); w.z = pk2(v1[0], v1[1]); w.w = pk2(v1[2], v1[3]);
                        *(u32x4*)(Kb + (size_t)row * 768 + head * 96 + w0) = w;
                    } else {
                        const int b = row >> 13, s = row & (SEQ - 1);
                        bf16_t* base = VT + ((size_t)((b * 8 + head) * 64 + (w0 - 64))) * SEQ + s;
#pragma unroll
                        for (int e = 0; e < 4; ++e) { base[(size_t)e * SEQ] = f2bf(v0[e]); base[(size_t)(4 + e) * SEQ] = f2bf(v1[e]); }
                    }
                }
        }
    }
};

DI void transpose_item(const float* W, int K, int N, int Npad, bf16_t* WT, float* scr, int item, int lane) {
    const int nblk = Npad / 32, kb = item / nblk, nb = item % nblk, k0 = 64 * kb, n0 = 32 * nb;
    const int n = n0 + (lane & 31);
#pragma unroll 8
    for (int i = 0; i < 32; ++i) { const int kk = 2 * i + (lane >> 5); scr[kk * 33 + (lane & 31)] = (n < N) ? W[(size_t)(k0 + kk) * N + n] : 0.f; }
    LDSFENCE();
    const int c = lane & 7;
#pragma unroll
    for (int j = 0; j < 4; ++j) { const int nn = (lane >> 3) + 8 * j; const float* s = scr + (8 * c) * 33 + nn;
        u32x4 o; o.x = pk2(s[0 * 33], s[1 * 33]); o.y = pk2(s[2 * 33], s[3 * 33]); o.z = pk2(s[4 * 33], s[5 * 33]); o.w = pk2(s[6 * 33], s[7 * 33]);
        *(u32x4*)(WT + (size_t)(n0 + nn) * K + k0 + 8 * c) = o; }
    LDSFENCE();
}
DI void row_pass(const bf16_t* src, const float* xin, const float* gpost, float* xout, const float* gnext, bf16_t* XN, int gw, int NGW, int lane) {
    for (int m0 = gw; m0 < M; m0 += 2 * NGW) {
        const int mm[2] = {m0, (m0 + NGW < M) ? m0 + NGW : m0};
        f32x4 xv[2][4]; f32x4 bv[2][4];
#pragma unroll
        for (int q = 0; q < 2; ++q)
#pragma unroll
            for (int j = 0; j < 4; ++j) xv[q][j] = *(const f32x4*)(xin + (size_t)mm[q] * DM + 4 * lane + 256 * j);
        if (src) {
            float ss[2] = {0.f, 0.f};
#pragma unroll
            for (int q = 0; q < 2; ++q)
#pragma unroll
                for (int j = 0; j < 4; ++j) { const u32x2 w = *(const u32x2*)(src + (size_t)mm[q] * DM + 4 * lane + 256 * j);
                    bv[q][j] = (f32x4){bflo(w.x), bfhi(w.x), bflo(w.y), bfhi(w.y)}; ss[q] += (bv[q][j].x * bv[q][j].x + bv[q][j].y * bv[q][j].y) + (bv[q][j].z * bv[q][j].z + bv[q][j].w * bv[q][j].w); }
#pragma unroll
            for (int q = 0; q < 2; ++q) {
                const float rs = rsqrtf(wave_sum(ss[q]) * (1.f / DM) + EPS);
                if (q == 0 || mm[1] != mm[0]) {
#pragma unroll
                    for (int j = 0; j < 4; ++j) { const f32x4 g = *(const f32x4*)(gpost + 4 * lane + 256 * j); xv[q][j] = xv[q][j] + bv[q][j] * rs * g;
                        *(f32x4*)(xout + (size_t)mm[q] * DM + 4 * lane + 256 * j) = xv[q][j]; }
                }
            }
        }
        if (gnext) {
#pragma unroll
            for (int q = 0; q < 2; ++q) {
                float s2 = 0.f;
#pragma unroll
                for (int j = 0; j < 4; ++j) s2 += (xv[q][j].x * xv[q][j].x + xv[q][j].y * xv[q][j].y) + (xv[q][j].z * xv[q][j].z + xv[q][j].w * xv[q][j].w);
                const float rs2 = rsqrtf(wave_sum(s2) * (1.f / DM) + EPS);
                if (q == 0 || mm[1] != mm[0]) {
#pragma unroll
                    for (int j = 0; j < 4; ++j) { const f32x4 g = *(const f32x4*)(gnext + 4 * lane + 256 * j); const f32x4 v = xv[q][j] * rs2 * g;
                        u32x2 o; o.x = pk2(v.x, v.y); o.y = pk2(v.z, v.w); *(u32x2*)(XN + (size_t)mm[q] * DM + 4 * lane + 256 * j) = o; }
                }
            }
        }
    }
}
DI void rope_tables(const int* positions, float* COS, float* SIN, int gtid, int NT) {
    for (int idx = gtid; idx < M * 16; idx += NT) {
        const int m = idx >> 4, i = idx & 15;
        double inv = (i & 3) == 0 ? 1.0 : ((i & 3) == 1 ? 0.5623413251903491 : ((i & 3) == 2 ? 0.31622776601683794 : 0.1778279410038923));
        const int dec = i >> 2; inv *= (dec == 0 ? 1.0 : (dec == 1 ? 0.1 : (dec == 2 ? 0.01 : 0.001)));
        const float ang_f = (float)positions[m] * (float)inv;
        const double ang = (double)ang_f;
        const double k = rint(ang * 0.15915494309189535); const double rr = ang - k * 6.283185307179586;
        const double hq = rr * 0.25, x2 = hq * hq;
        const double s = hq * (1.0 - x2 / 6.0 * (1.0 - x2 / 20.0 * (1.0 - x2 / 42.0 * (1.0 - x2 / 72.0 * (1.0 - x2 / 110.0 * (1.0 - x2 / 156.0))))));
        const double c = 1.0 - x2 / 2.0 * (1.0 - x2 / 12.0 * (1.0 - x2 / 30.0 * (1.0 - x2 / 56.0 * (1.0 - x2 / 90.0 * (1.0 - x2 / 132.0)))));
        const double s2 = 2.0 * s * c, c2 = 1.0 - 2.0 * s * s; const double s4 = 2.0 * s2 * c2, c4 = 1.0 - 2.0 * s2 * s2;
        COS[idx] = (float)c4; SIN[idx] = (float)s4;
    }
}
DI void prep_rows(const bf16_t* PROJ, const float* qn, const float* kvn, const float* COS, const float* SIN, bf16_t* CQN, bf16_t* CKVN, bf16_t* Kb, int gw, int NGW, int lane) {
    for (int m = gw; m < M; m += NGW) {
        const bf16_t* pr = PROJ + (size_t)m * NPROJ;
        { const u32x2 w = *(const u32x2*)(pr + C_CQ + 4 * lane); const float c0 = bflo(w.x), c1 = bfhi(w.x), c2 = bflo(w.y), c3 = bfhi(w.y);
          const float ss = wave_sum((c0 * c0 + c1 * c1) + (c2 * c2 + c3 * c3)); const float rs = rsqrtf(ss * (1.f / 256.f) + EPS);
          const f32x4 g = *(const f32x4*)(qn + 4 * lane);
          u32x2 o; o.x = pk2(c0 * rs * g.x, c1 * rs * g.y); o.y = pk2(c2 * rs * g.z, c3 * rs * g.w); *(u32x2*)(CQN + (size_t)m * 256 + 4 * lane) = o; }
        { const unsigned w = *(const unsigned*)(pr + C_CKV + 2 * lane); const float c0 = bflo(w), c1 = bfhi(w);
          const float ss = wave_sum(c0 * c0 + c1 * c1); const float rs = rsqrtf(ss * (1.f / 128.f) + EPS);
          *(unsigned*)(CKVN + (size_t)m * 128 + 2 * lane) = pk2(c0 * rs * kvn[2 * lane], c1 * rs * kvn[2 * lane + 1]); }
        { const int i = lane & 15; const float x1 = bf2f(pr[C_KR + i]), x2 = bf2f(pr[C_KR + 16 + i]); const float c = COS[(size_t)m * 16 + i], s = SIN[(size_t)m * 16 + i];
          const float o = (lane & 16) ? (x1 * s + x2 * c) : (x1 * c - x2 * s);
          if (lane < 32) { const bf16_t ob = f2bf(o);
#pragma unroll
              for (int hh = 0; hh < 8; ++hh) Kb[(size_t)m * 768 + hh * 96 + 64 + lane] = ob; } }
    }
}

constexpr int AK_STRIDE = 208, AV_STRIDE = 144, AK_BYTES = 64 * AK_STRIDE, AV_BYTES = 64 * AV_STRIDE;
constexpr int A_KOFF = 0, A_VOFF = 2 * AK_BYTES, A_WS = A_VOFF + 2 * AV_BYTES;
DI void pv_half(f32x16 (&o)[2], const f32x16& P, const char* Vb, int kvhalf, int r, int h) {
#pragma unroll
    for (int s = 0; s < 2; ++s) {
        u32x4 pa; pa.x = pk2(P[8 * s + 0], P[8 * s + 1]); pa.y = pk2(P[8 * s + 2], P[8 * s + 3]); pa.z = pk2(P[8 * s + 4], P[8 * s + 5]); pa.w = pk2(P[8 * s + 6], P[8 * s + 7]);
        const bf16x8 a = __builtin_bit_cast(bf16x8, pa);
#pragma unroll
        for (int dt = 0; dt < 2; ++dt) {
            const bf16x8 b = *(const bf16x8*)(Vb + (dt * 32 + r) * AV_STRIDE + (kvhalf * 32 + 16 * s + 8 * h) * 2);
            o[dt] = MFMA32(a, b, o[dt]);
        }
    }
}
DI void attn_unit(const bf16_t* Q, const bf16_t* K, const bf16_t* VT, bf16_t* HM, int b, int head, int qb, char* lds, const int wave_s) {
    const int tid = tid_opaque(wave_s), lane = tid & 63, wid = wave_s, r = lane & 31, h = lane >> 5;
    const int q0 = qb * 256; const size_t rowbase = (size_t)b * SEQ;
    bf16x8 qf[6];
    { const bf16_t* Qp = Q + (rowbase + q0 + wid * 32 + r) * 768 + head * 96 + 8 * h;
#pragma unroll
      for (int d0 = 0; d0 < 6; ++d0) qf[d0] = *(const bf16x8*)(Qp + 16 * d0); }
    const int NT = (q0 + 256) / 64;
    const int kr0 = tid / 12, kc0 = tid % 12, kr1 = (tid + 512) / 12, kc1 = (tid + 512) % 12;
    const bool k2 = tid < 256;
    const bf16_t* kg0 = K + (rowbase + kr0) * 768 + head * 96 + kc0 * 8;
    const bf16_t* kg1 = K + (rowbase + kr1) * 768 + head * 96 + kc1 * 8;
    const int vr = tid >> 3, vc = tid & 7;
    const bf16_t* vg = VT + ((size_t)((b * 8 + head) * 64 + vr)) * SEQ + vc * 8;
    char* kl0 = lds + A_KOFF + kr0 * AK_STRIDE + kc0 * 16; char* kl1 = lds + A_KOFF + kr1 * AK_STRIDE + kc1 * 16;
    char* vl = lds + A_VOFF + vr * AV_STRIDE + (16 * (vc >> 1) + 4 * (vc & 1)) * 2;
    float* wsf = (float*)(lds + A_WS) + wid * 64;
    u32x4 kreg0, kreg1 = (u32x4){0u, 0u, 0u, 0u}, vreg;
    kreg0 = *(const u32x4*)kg0; if (k2) kreg1 = *(const u32x4*)kg1; vreg = *(const u32x4*)vg;
    *(u32x4*)kl0 = kreg0; if (k2) *(u32x4*)kl1 = kreg1; *(u32x2*)(vl) = (u32x2){vreg.x, vreg.y}; *(u32x2*)(vl + 16) = (u32x2){vreg.z, vreg.w};
    __syncthreads();
    float m_old = -INFINITY, l = 0.f; f32x16 o[2];
#pragma unroll
    for (int i = 0; i < 16; ++i) { o[0][i] = 0.f; o[1][i] = 0.f; }
    const int qg = q0 + wid * 32 + r;
    for (int t = 0; t < NT; ++t) {
        const bool more = (t + 1 < NT);
        if (more) { kreg0 = *(const u32x4*)(kg0 + (size_t)(t + 1) * 64 * 768); if (k2) kreg1 = *(const u32x4*)(kg1 + (size_t)(t + 1) * 64 * 768); vreg = *(const u32x4*)(vg + (t + 1) * 64); }
        const char* Kb = lds + A_KOFF + (t & 1) * AK_BYTES; const char* Vb = lds + A_VOFF + (t & 1) * AV_BYTES;
        f32x16 p0, p1;
#pragma unroll
        for (int i = 0; i < 16; ++i) { p0[i] = 0.f; p1[i] = 0.f; }
#pragma unroll
        for (int d0 = 0; d0 < 6; ++d0) {
            const bf16x8 a0 = *(const bf16x8*)(Kb + r * AK_STRIDE + (16 * d0 + 8 * h) * 2);
            const bf16x8 a1 = *(const bf16x8*)(Kb + (32 + r) * AK_STRIDE + (16 * d0 + 8 * h) * 2);
            p0 = MFMA32(a0, qf[d0], p0); p1 = MFMA32(a1, qf[d0], p1);
        }
        if (t >= NT - 4) {
            const int kvb = t * 64;
#pragma unroll
            for (int i = 0; i < 16; ++i) { const int kv = kvb + crow(i, h); if (kv > qg) p0[i] = -INFINITY; if (kv + 32 > qg) p1[i] = -INFINITY; }
        }
        float rm = fmaxf(p0[0], p1[0]);
#pragma unroll
        for (int i = 1; i < 16; ++i) rm = fmaxf(rm, fmaxf(p0[i], p1[i]));
        rm = fmaxf(rm, __shfl_xor(rm, 32));
        const float m_new = fmaxf(m_old, rm);
        const float alpha = __builtin_amdgcn_exp2f(m_old - m_new);
        m_old = m_new;
        float ps = 0.f;
#pragma unroll
        for (int i = 0; i < 16; ++i) { p0[i] = __builtin_amdgcn_exp2f(p0[i] - m_new); p1[i] = __builtin_amdgcn_exp2f(p1[i] - m_new); ps += p0[i] + p1[i]; }
        l = l * alpha + ps;
        if (__any(alpha != 1.f)) {
            if (h == 0) wsf[r] = alpha;
            LDSFENCE();
#pragma unroll
            for (int g = 0; g < 4; ++g) { const f32x4 f = *(const f32x4*)(wsf + 8 * g + 4 * h);
#pragma unroll
                for (int e = 0; e < 4; ++e) { o[0][4 * g + e] *= f[e]; o[1][4 * g + e] *= f[e]; } }
            LDSFENCE();
        }
        pv_half(o, p0, Vb, 0, r, h);
        pv_half(o, p1, Vb, 1, r, h);
        if (more) { char* kd0 = kl0 + ((t + 1) & 1) * AK_BYTES; char* kd1 = kl1 + ((t + 1) & 1) * AK_BYTES; char* vd = vl + ((t + 1) & 1) * AV_BYTES;
            *(u32x4*)kd0 = kreg0; if (k2) *(u32x4*)kd1 = kreg1; *(u32x2*)vd = (u32x2){vreg.x, vreg.y}; *(u32x2*)(vd + 16) = (u32x2){vreg.z, vreg.w}; }
        __syncthreads();
    }
    l += __shfl_xor(l, 32);
    if (h == 0) wsf[r] = 1.f / l;
    LDSFENCE();
    bf16_t* Op = HM + (rowbase + q0 + wid * 32) * 1024 + 512 + head * 64 + r;
#pragma unroll
    for (int g = 0; g < 4; ++g) { const f32x4 f = *(const f32x4*)(wsf + 8 * g + 4 * h);
#pragma unroll
        for (int e = 0; e < 4; ++e) { const int row = 8 * g + 4 * h + e;
            Op[(size_t)row * 1024] = f2bf(o[0][4 * g + e] * f[e]); Op[(size_t)row * 1024 + 32] = f2bf(o[1][4 * g + e] * f[e]); } }
    LDSFENCE();
    __syncthreads();
}

constexpr float ATHR = 8.f;
DI float rowmax32(const f32x16& a, const f32x16& b) {
    float x = fmaxf(a[0], b[0]);
#pragma unroll
    for (int i = 1; i < 16; ++i) x = fmaxf(x, fmaxf(a[i], b[i]));
    auto rr = __builtin_amdgcn_permlane32_swap(__float_as_uint(x), __float_as_uint(x), false, false);
    return fmaxf(__uint_as_float(rr[0]), __uint_as_float(rr[1]));
}
DI void attn_mask(f32x16& p0, f32x16& p1, int kvb, int qg, int h) {
#pragma unroll
    for (int i = 0; i < 16; ++i) { const int kv = kvb + crow(i, h); if (kv > qg) p0[i] = -INFINITY; if (kv + 32 > qg) p1[i] = -INFINITY; }
}
DI void attn_qk(f32x16& n0, f32x16& n1, const bf16x8 (&qf)[6], const f32x16& negm, const char* Kb, int r, int h) {
#pragma unroll
    for (int d0 = 0; d0 < 6; ++d0) {
        const bf16x8 a0 = *(const bf16x8*)(Kb + r * AK_STRIDE + (16 * d0 + 8 * h) * 2);
        const bf16x8 a1 = *(const bf16x8*)(Kb + (32 + r) * AK_STRIDE + (16 * d0 + 8 * h) * 2);
        if (d0 == 0) { n0 = MFMA32(a0, qf[0], negm); n1 = MFMA32(a1, qf[0], negm); }
        else { n0 = MFMA32(a0, qf[d0], n0); n1 = MFMA32(a1, qf[d0], n1); }
    }
}
DI void attn_shift(f32x16& n0, f32x16& n1, f32x16& negm, float& mref, float& l, f32x16 (&o)[2], float dl, float* wsf, int r, int h) {
    mref += dl;
#pragma unroll
    for (int i = 0; i < 16; ++i) { n0[i] -= dl; n1[i] -= dl; negm[i] = -mref; }
    const float f = __builtin_amdgcn_exp2f(-dl); l *= f;
    if (h == 0) wsf[r] = f;
    LDSFENCE();
#pragma unroll
    for (int g = 0; g < 4; ++g) { const f32x4 ff = *(const f32x4*)(wsf + 8 * g + 4 * h);
#pragma unroll
        for (int e = 0; e < 4; ++e) { o[0][4 * g + e] *= ff[e]; o[1][4 * g + e] *= ff[e]; } }
    LDSFENCE();
}
DI bf16x8 lds_read128_async(unsigned addr, int off) { bf16x8 v; asm volatile("ds_read_b128 %0, %1 offset:%2" : "=v"(v) : "v"(addr), "i"(off) : "memory"); return v; }
template <bool HASNEXT>
DI void attn_step(f32x16& c0, f32x16& c1, f32x16& n0, f32x16& n1, const bf16x8 (&qf)[6], f32x16& negm, float& mref, float& l, f32x16 (&o)[2],
                  const char* Kn, const char* Vc, float* wsf, bool masknext, int kvb_next, int qg, int r, int h) {
    bf16x8 vf[8];
    { const unsigned va = (unsigned)(uintptr_t)(Vc + r * AV_STRIDE + 16 * h);
#pragma unroll
      for (int i = 0; i < 8; ++i) vf[i] = lds_read128_async(va, ((i & 1) * 32) * AV_STRIDE + (i >> 2) * 64 + ((i >> 1) & 1) * 32); }
    if (HASNEXT) attn_qk(n0, n1, qf, negm, Kn, r, h);
#pragma unroll
    for (int i = 0; i < 16; ++i) { c0[i] = __builtin_amdgcn_exp2f(c0[i]); c1[i] = __builtin_amdgcn_exp2f(c1[i]); }
    f32x2_t s2 = {0.f, 0.f};
#pragma unroll
    for (int i = 0; i < 8; ++i) { s2 += (f32x2_t){c0[2 * i], c0[2 * i + 1]}; s2 += (f32x2_t){c1[2 * i], c1[2 * i + 1]}; }
    l += s2.x + s2.y;
    asm volatile("s_waitcnt lgkmcnt(0)" : "+v"(vf[0]), "+v"(vf[1]), "+v"(vf[2]), "+v"(vf[3]), "+v"(vf[4]), "+v"(vf[5]), "+v"(vf[6]), "+v"(vf[7]) :: "memory");
#pragma unroll
    for (int kh = 0; kh < 2; ++kh)
#pragma unroll
        for (int s = 0; s < 2; ++s) {
            u32x4 pa;
            if (kh == 0) { pa.x = pk2(c0[8 * s + 0], c0[8 * s + 1]); pa.y = pk2(c0[8 * s + 2], c0[8 * s + 3]); pa.z = pk2(c0[8 * s + 4], c0[8 * s + 5]); pa.w = pk2(c0[8 * s + 6], c0[8 * s + 7]); }
            else         { pa.x = pk2(c1[8 * s + 0], c1[8 * s + 1]); pa.y = pk2(c1[8 * s + 2], c1[8 * s + 3]); pa.z = pk2(c1[8 * s + 4], c1[8 * s + 5]); pa.w = pk2(c1[8 * s + 6], c1[8 * s + 7]); }
            const bf16x8 a = __builtin_bit_cast(bf16x8, pa);
            o[0] = MFMA32(a, vf[kh * 4 + s * 2 + 0], o[0]);
            o[1] = MFMA32(a, vf[kh * 4 + s * 2 + 1], o[1]);
        }
    if (HASNEXT) {
#pragma unroll
        for (int i = 0; i < 12; ++i) { __builtin_amdgcn_sched_group_barrier(0x008, 1, 0); __builtin_amdgcn_sched_group_barrier(0x402, 6, 0); }
        if (masknext) attn_mask(n0, n1, kvb_next, qg, h);
        const float rm = rowmax32(n0, n1);
        if (__any(rm > ATHR)) attn_shift(n0, n1, negm, mref, l, o, fmaxf(rm, 0.f), wsf, r, h);
    }
}
DI void attn_unit2(const bf16_t* Q, const bf16_t* K, const bf16_t* VT, bf16_t* HM, int b, int head, int qb, char* lds, const int wave_s) {
    const int tid = tid_opaque(wave_s), lane = tid & 63, wid = wave_s, r = lane & 31, h = lane >> 5;
    const int q0 = qb * 256; const size_t rowbase = (size_t)b * SEQ;
    bf16x8 qf[6];
    { const bf16_t* Qp = Q + (rowbase + q0 + wid * 32 + r) * 768 + head * 96 + 8 * h;
#pragma unroll
      for (int d0 = 0; d0 < 6; ++d0) qf[d0] = *(const bf16x8*)(Qp + 16 * d0); }
    const int NT = (q0 + 256) / 64;
    const int kr0 = tid / 12, kc0 = tid % 12, kr1 = (tid + 512) / 12, kc1 = (tid + 512) % 12;
    const bool k2 = tid < 256;
    const bf16_t* kg0 = K + (rowbase + kr0) * 768 + head * 96 + kc0 * 8;
    const bf16_t* kg1 = K + (rowbase + kr1) * 768 + head * 96 + kc1 * 8;
    const int vr = tid >> 3, vc = tid & 7;
    const bf16_t* vg = VT + ((size_t)((b * 8 + head) * 64 + vr)) * SEQ + vc * 8;
    char* kl0 = lds + A_KOFF + kr0 * AK_STRIDE + kc0 * 16; char* kl1 = lds + A_KOFF + kr1 * AK_STRIDE + kc1 * 16;
    char* vl = lds + A_VOFF + vr * AV_STRIDE + (16 * (vc >> 1) + 4 * (vc & 1)) * 2;
    float* wsf = (float*)(lds + A_WS) + wid * 64;
    u32x4 kreg0, kreg1 = (u32x4){0u, 0u, 0u, 0u}, vreg;
#define A2_LOADK(j) do { kreg0 = *(const u32x4*)(kg0 + (size_t)(j) * 64 * 768); if (k2) kreg1 = *(const u32x4*)(kg1 + (size_t)(j) * 64 * 768); } while (0)
#define A2_LOADV(j) do { vreg = *(const u32x4*)(vg + (j) * 64); } while (0)
#define A2_STOREK(j) do { *(u32x4*)(kl0 + ((j) & 1) * AK_BYTES) = kreg0; if (k2) *(u32x4*)(kl1 + ((j) & 1) * AK_BYTES) = kreg1; } while (0)
#define A2_STOREV(j) do { char* vd_ = vl + ((j) & 1) * AV_BYTES; *(u32x2*)vd_ = (u32x2){vreg.x, vreg.y}; *(u32x2*)(vd_ + 16) = (u32x2){vreg.z, vreg.w}; } while (0)
    A2_LOADK(0); A2_LOADV(0); A2_STOREK(0); A2_STOREV(0);
    A2_LOADK(1); A2_STOREK(1);
    __syncthreads();
    float mref = 0.f, l = 0.f; f32x16 o[2], negm, sA0, sA1, sB0, sB1;
#pragma unroll
    for (int i = 0; i < 16; ++i) { o[0][i] = 0.f; o[1][i] = 0.f; negm[i] = 0.f; sB0[i] = 0.f; sB1[i] = 0.f; }
    const int qg = q0 + wid * 32 + r;
    attn_qk(sA0, sA1, qf, negm, lds + A_KOFF, r, h);
    if (NT == 4) attn_mask(sA0, sA1, 0, qg, h);
    { const float rm = rowmax32(sA0, sA1); attn_shift(sA0, sA1, negm, mref, l, o, rm, wsf, r, h); }
    __syncthreads();
#define A2_STEP(t, C0, C1, N0, N1) do { \
        const bool ldk_ = ((t) + 2 < NT), ldv_ = ((t) + 1 < NT); \
        if (ldk_) A2_LOADK((t) + 2); if (ldv_) A2_LOADV((t) + 1); \
        attn_step<true>(C0, C1, N0, N1, qf, negm, mref, l, o, lds + A_KOFF + (((t) + 1) & 1) * AK_BYTES, lds + A_VOFF + ((t) & 1) * AV_BYTES, wsf, ((t) + 1 >= NT - 4), ((t) + 1) * 64, qg, r, h); \
        if (ldk_) A2_STOREK((t) + 2); if (ldv_) A2_STOREV((t) + 1); \
        __syncthreads(); } while (0)
    int t = 0;
    for (; t < NT - 2; t += 2) { A2_STEP(t, sA0, sA1, sB0, sB1); A2_STEP(t + 1, sB0, sB1, sA0, sA1); }
    A2_STEP(t, sA0, sA1, sB0, sB1);
    attn_step<false>(sB0, sB1, sA0, sA1, qf, negm, mref, l, o, lds, lds + A_VOFF + ((NT - 1) & 1) * AV_BYTES, wsf, false, 0, qg, r, h);
#undef A2_STEP
#undef A2_LOADK
#undef A2_LOADV
#undef A2_STOREK
#undef A2_STOREV
    { auto rr = __builtin_amdgcn_permlane32_swap(__float_as_uint(l), __float_as_uint(l), false, false); l = __uint_as_float(rr[0]) + __uint_as_float(rr[1]); }
    if (h == 0) wsf[r] = 1.f / l;
    LDSFENCE();
    bf16_t* Op = HM + (rowbase + q0 + wid * 32) * 1024 + 512 + head * 64 + r;
#pragma unroll
    for (int g = 0; g < 4; ++g) { const f32x4 f = *(const f32x4*)(wsf + 8 * g + 4 * h);
#pragma unroll
        for (int e = 0; e < 4; ++e) { const int row = 8 * g + 4 * h + e;
            Op[(size_t)row * 1024] = f2bf(o[0][4 * g + e] * f[e]); Op[(size_t)row * 1024 + 32] = f2bf(o[1][4 * g + e] * f[e]); } }
    LDSFENCE();
    __syncthreads();
}

DI void conv8(const bf16_t* PROJ, size_t rowbase, int t, int col, const float* cw, const float* cb, float (&out)[8]) {
    float acc[8];
    { const f32x4 b0 = *(const f32x4*)(cb + col), b1 = *(const f32x4*)(cb + col + 4);
      acc[0] = b0.x; acc[1] = b0.y; acc[2] = b0.z; acc[3] = b0.w; acc[4] = b1.x; acc[5] = b1.y; acc[6] = b1.z; acc[7] = b1.w; }
#pragma unroll
    for (int k = 0; k < 4; ++k) {
        const int tt = t - 3 + k;
        if (tt >= 0) {
            const u32x4 w = *(const u32x4*)(PROJ + (rowbase + tt) * NPROJ + col);
            const f32x4 w0 = *(const f32x4*)(cw + k * 512 + col), w1 = *(const f32x4*)(cw + k * 512 + col + 4);
            acc[0] += w0.x * bflo(w.x); acc[1] += w0.y * bfhi(w.x); acc[2] += w0.z * bflo(w.y); acc[3] += w0.w * bfhi(w.y);
            acc[4] += w1.x * bflo(w.z); acc[5] += w1.y * bfhi(w.z); acc[6] += w1.z * bflo(w.w); acc[7] += w1.w * bfhi(w.w);
        }
    }
#pragma unroll
    for (int j = 0; j < 8; ++j) out[j] = acc[j] / (1.f + __expf(-acc[j]));
}
DI float log_sigmoid(float f) { return fminf(f, 0.f) - log1pf(__expf(-fabsf(f))); }
DI float scan_add(float x, int lane) {
#pragma unroll
    for (int o = 1; o < 64; o <<= 1) { const float t = __shfl_up(x, o); if (lane >= o) x += t; }
    return x;
}
DI float scan_max(float x, int lane) {
#pragma unroll
    for (int o = 1; o < 64; o <<= 1) { const float t = __shfl_up(x, o); if (lane >= o) x = fmaxf(x, t); }
    return x;
}
constexpr int ML_S64 = 72, ML_S128 = 136;
DI void mlstm_local_unit(const bf16_t* PROJ, const float* cw, const float* cb, const float* bg, float* CS, float* NLOC, float* MLOC, float* BEND, int bh, int c, char* lds, const int wave_s) {
    const int tid = tid_opaque(wave_s), lane = tid & 63, wid = wave_s, r = lane & 31, h = lane >> 5;
    const int b = bh >> 2, hd = bh & 3; const size_t rowbase = (size_t)b * SEQ; const int t0 = c * 64;
    bf16_t* KWT = (bf16_t*)lds;
    bf16_t* VTl = (bf16_t*)(lds + 64 * ML_S64 * 2);
    float* Wl = (float*)(lds + 64 * ML_S64 * 2 + 128 * ML_S64 * 2);
    if (wid == 0) {
        const bf16_t* pr = PROJ + (rowbase + t0 + lane) * NPROJ + C_G;
        const float ig = bf2f(pr[hd]) + bg[hd], fp = bf2f(pr[4 + hd]) + bg[4 + hd];
        const float bc = scan_add(log_sigmoid(fp), lane);
        const float bend = __shfl(bc, 63);
        const float a = bend - bc + ig;
        const float ml = wave_max(a);
        Wl[lane] = __expf(a - ml);
        if (lane == 0) { MLOC[bh * NCH + c] = ml; BEND[bh * NCH + c] = bend; }
    }
    __syncthreads();
    { const int row = tid >> 3, c8 = (tid & 7) * 8; float kv[8];
      conv8(PROJ, rowbase, t0 + row, 256 + 64 * hd + c8, cw, cb, kv);
      const float w = Wl[row] * 0.125f;
#pragma unroll
      for (int j = 0; j < 8; ++j) KWT[(c8 + j) * ML_S64 + row] = f2bf(kv[j] * w);
      const int e16 = (tid & 7) * 16;
      const u32x4 v0 = *(const u32x4*)(PROJ + (rowbase + t0 + row) * NPROJ + C_V + 128 * hd + e16), v1 = *(const u32x4*)(PROJ + (rowbase + t0 + row) * NPROJ + C_V + 128 * hd + e16 + 8);
      const unsigned vw[8] = {v0.x, v0.y, v0.z, v0.w, v1.x, v1.y, v1.z, v1.w};
#pragma unroll
      for (int j = 0; j < 8; ++j) { VTl[(e16 + 2 * j) * ML_S64 + row] = (bf16_t)(vw[j] & 0xffffu); VTl[(e16 + 2 * j + 1) * ML_S64 + row] = (bf16_t)(vw[j] >> 16); } }
    __syncthreads();
    { const int et = wid >> 1, dtile = wid & 1; f32x16 acc;
#pragma unroll
      for (int i = 0; i < 16; ++i) acc[i] = 0.f;
#pragma unroll
      for (int ks = 0; ks < 4; ++ks) { const bf16x8 a = *(const bf16x8*)(VTl + (32 * et + r) * ML_S64 + 16 * ks + 8 * h); const bf16x8 bb = *(const bf16x8*)(KWT + (32 * dtile + r) * ML_S64 + 16 * ks + 8 * h);
          acc = MFMA32(a, bb, acc); }
      float* Cp = CS + ((size_t)(bh * NCH + c) * 128 + 32 * et) * 64 + 32 * dtile + r;
#pragma unroll
      for (int i = 0; i < 16; ++i) Cp[(size_t)crow(i, h) * 64] = acc[i];
      if (tid < 64) { float s = 0.f;
#pragma unroll 8
          for (int l2 = 0; l2 < 64; ++l2) s += bf2f(KWT[tid * ML_S64 + l2]);
          NLOC[(size_t)(bh * NCH + c) * 64 + tid] = s; } }
    __syncthreads();
}
DI void mlstm_scan(float* CS, float* NLOC, const float* MLOC, const float* BEND, float* MPREV, int job, char* lds, const int wave_s) {
    const int tid = tid_opaque(wave_s); const int bh = job / 17, e = (job % 17) * 512 + tid;
    float* SP = (float*)lds; float* SL = SP + 128; float* BL = SP + 256; float* ML = SP + 384;
    if (tid < NCH) { BL[tid] = BEND[bh * NCH + tid]; ML[tid] = MLOC[bh * NCH + tid]; }
    const bool act = e < 8192 + 64;
    float* p = CS; size_t stride = 8192;
    if (act) { if (e < 8192) { p = CS + (size_t)bh * NCH * 8192 + e; stride = 8192; } else { p = NLOC + (size_t)bh * NCH * 64 + (e - 8192); stride = 64; } }
    float v[16];
    if (act) {
#pragma unroll
        for (int u = 0; u < 16; ++u) v[u] = p[(size_t)u * stride];
    }
    __syncthreads();
    if (tid == 0) { float m = 0.f;
        for (int c = 0; c < NCH; ++c) { const float bl = BL[c], ml = ML[c]; const float mn = fmaxf(bl + m, ml);
            SP[c] = __expf(bl + m - mn); SL[c] = __expf(ml - mn); BL[c] = m; m = mn; } }
    __syncthreads();
    if (job % 17 == 0 && tid < NCH) MPREV[bh * NCH + tid] = BL[tid];
    if (act) {
        float C = 0.f;
        for (int c0 = 0; c0 < NCH; c0 += 16) {
            float w[16] = {0.f, 0.f, 0.f, 0.f, 0.f, 0.f, 0.f, 0.f, 0.f, 0.f, 0.f, 0.f, 0.f, 0.f, 0.f, 0.f};
            if (c0 + 16 < NCH) {
#pragma unroll
                for (int u = 0; u < 16; ++u) w[u] = p[(size_t)(c0 + 16 + u) * stride];
            }
#pragma unroll
            for (int u = 0; u < 16; ++u) { p[(size_t)(c0 + u) * stride] = C; C = SP[c0 + u] * C + SL[c0 + u] * v[u]; }
#pragma unroll
            for (int u = 0; u < 16; ++u) v[u] = w[u];
        }
    }
    __syncthreads();
}
constexpr int MO_QS = 0, MO_KS = 9216, MO_AM = 18432, MO_BM = 35840, MO_HS = 70656, MO_G = 104448;
DI void mlstm_out_unit(const bf16_t* PROJ, const float* cw, const float* cb, const float* bg, const float* hnorm, const float* CS, const float* NPREV, const float* MPREV, bf16_t* HM, int bh, int c, char* lds, const int wave_s) {
    const int tid = tid_opaque(wave_s), lane = tid & 63, wid = wave_s, r = lane & 31, h = lane >> 5;
    const int b = bh >> 2, hd = bh & 3; const size_t rowbase = (size_t)b * SEQ; const int t0 = c * 64;
    bf16_t* QS = (bf16_t*)(lds + MO_QS); bf16_t* KS = (bf16_t*)(lds + MO_KS); bf16_t* AM = (bf16_t*)(lds + MO_AM); bf16_t* BM = (bf16_t*)(lds + MO_BM);
    float* HS = (float*)(lds + MO_HS); float* G = (float*)(lds + MO_G);
    float* G_U = G, *G_VI = G + 64, *G_IW = G + 128, *G_EN = G + 192, *G_NP = G + 256, *G_DEN = G + 320;
    if (wid == 0) {
        const bf16_t* pr = PROJ + (rowbase + t0 + lane) * NPROJ + C_G;
        const float ig = bf2f(pr[hd]) + bg[hd], fp = bf2f(pr[4 + hd]) + bg[4 + hd];
        const float bc = scan_add(log_sigmoid(fp), lane);
        const float u = ig - bc;
        const float pm = scan_max(u, lane);
        const float mp = MPREV[bh * NCH + c];
        const float mx = fmaxf(pm, mp);
        G_U[lane] = u; G_VI[lane] = -mx; G_IW[lane] = __expf(mp - mx); G_EN[lane] = __expf(-(bc + mx));
    } else if (wid == 1) {
        G_NP[lane] = NPREV[(size_t)(bh * NCH + c) * 64 + lane];
    }
    __syncthreads();
    { const int row = tid >> 3, c8 = (tid & 7) * 8; float qv[8], kv[8];
      conv8(PROJ, rowbase, t0 + row, 64 * hd + c8, cw, cb, qv);
      conv8(PROJ, rowbase, t0 + row, 256 + 64 * hd + c8, cw, cb, kv);
      const float iw = G_IW[row];
      u32x4 qq, kk, qw;
      qq.x = pk2(qv[0], qv[1]); qq.y = pk2(qv[2], qv[3]); qq.z = pk2(qv[4], qv[5]); qq.w = pk2(qv[6], qv[7]);
      kk.x = pk2(kv[0] * 0.125f, kv[1] * 0.125f); kk.y = pk2(kv[2] * 0.125f, kv[3] * 0.125f); kk.z = pk2(kv[4] * 0.125f, kv[5] * 0.125f); kk.w = pk2(kv[6] * 0.125f, kv[7] * 0.125f);
      qw.x = pk2(qv[0] * iw, qv[1] * iw); qw.y = pk2(qv[2] * iw, qv[3] * iw); qw.z = pk2(qv[4] * iw, qv[5] * iw); qw.w = pk2(qv[6] * iw, qv[7] * iw);
      *(u32x4*)(QS + row * ML_S64 + c8) = qq; *(u32x4*)(KS + row * ML_S64 + c8) = kk; *(u32x4*)(AM + row * ML_S128 + 64 + c8) = qw;
      const int e16 = (tid & 7) * 16;
      const u32x4 v0 = *(const u32x4*)(PROJ + (rowbase + t0 + row) * NPROJ + C_V + 128 * hd + e16), v1 = *(const u32x4*)(PROJ + (rowbase + t0 + row) * NPROJ + C_V + 128 * hd + e16 + 8);
      const unsigned vw[8] = {v0.x, v0.y, v0.z, v0.w, v1.x, v1.y, v1.z, v1.w};
#pragma unroll
      for (int j = 0; j < 8; ++j) { BM[(e16 + 2 * j) * ML_S128 + row] = (bf16_t)(vw[j] & 0xffffu); BM[(e16 + 2 * j + 1) * ML_S128 + row] = (bf16_t)(vw[j] >> 16); }
      const int e = tid >> 2, d16 = (tid & 3) * 16;
      const float* cp = CS + ((size_t)(bh * NCH + c) * 128 + e) * 64 + d16;
      const f32x4 a0 = *(const f32x4*)cp, a1 = *(const f32x4*)(cp + 4), a2 = *(const f32x4*)(cp + 8), a3 = *(const f32x4*)(cp + 12);
      u32x4 c0, c1; c0.x = pk2(a0.x, a0.y); c0.y = pk2(a0.z, a0.w); c0.z = pk2(a1.x, a1.y); c0.w = pk2(a1.z, a1.w); c1.x = pk2(a2.x, a2.y); c1.y = pk2(a2.z, a2.w); c1.z = pk2(a3.x, a3.y); c1.w = pk2(a3.z, a3.w);
      *(u32x4*)(BM + e * ML_S128 + 64 + d16) = c0; *(u32x4*)(BM + e * ML_S128 + 64 + d16 + 8) = c1; }
    __syncthreads();
    if (wid < 4) {
        const int it = wid >> 1, jt = wid & 1; f32x16 acc;
#pragma unroll
        for (int i = 0; i < 16; ++i) acc[i] = 0.f;
        if (jt <= it) {
#pragma unroll
            for (int ks = 0; ks < 4; ++ks) { const bf16x8 a = *(const bf16x8*)(QS + (32 * it + r) * ML_S64 + 16 * ks + 8 * h); const bf16x8 bb = *(const bf16x8*)(KS + (32 * jt + r) * ML_S64 + 16 * ks + 8 * h);
                acc = MFMA32(a, bb, acc); }
        }
        const int j = 32 * jt + r; const float uj = G_U[j];
#pragma unroll
        for (int i2 = 0; i2 < 16; ++i2) { const int i = 32 * it + crow(i2, h);
            const float sv = (j <= i) ? acc[i2] * __expf(uj + G_VI[i]) : 0.f;
            AM[i * ML_S128 + j] = f2bf(sv); }
    }
    __syncthreads();
    { if (tid < 64) { float den = 0.f;
#pragma unroll 8
          for (int j = 0; j < 64; ++j) den += bf2f(AM[tid * ML_S128 + j]);
#pragma unroll 8
          for (int d = 0; d < 64; ++d) den += bf2f(AM[tid * ML_S128 + 64 + d]) * G_NP[d];
          G_DEN[tid] = 1.f / fmaxf(fabsf(den), G_EN[tid]); }
      const int it = wid >> 2, et = wid & 3; f32x16 acc;
#pragma unroll
      for (int i = 0; i < 16; ++i) acc[i] = 0.f;
#pragma unroll
      for (int ks = 0; ks < 8; ++ks) { const bf16x8 a = *(const bf16x8*)(AM + (32 * it + r) * ML_S128 + 16 * ks + 8 * h); const bf16x8 bb = *(const bf16x8*)(BM + (32 * et + r) * ML_S128 + 16 * ks + 8 * h);
          acc = MFMA32(a, bb, acc); }
#pragma unroll
      for (int i2 = 0; i2 < 16; ++i2) HS[(32 * it + crow(i2, h)) * 132 + 32 * et + r] = acc[i2]; }
    __syncthreads();
    { const int i = tid >> 3, p = tid & 7, e0 = p * 16; const float dn = G_DEN[i];
      float v[16]; float ss = 0.f;
#pragma unroll
      for (int q4 = 0; q4 < 4; ++q4) { const f32x4 x = *(const f32x4*)(HS + i * 132 + e0 + 4 * q4); v[4 * q4] = x.x * dn; v[4 * q4 + 1] = x.y * dn; v[4 * q4 + 2] = x.z * dn; v[4 * q4 + 3] = x.w * dn; }
#pragma unroll
      for (int j = 0; j < 16; ++j) ss += v[j] * v[j];
      ss += __shfl_xor(ss, 1); ss += __shfl_xor(ss, 2); ss += __shfl_xor(ss, 4);
      const float rs = rsqrtf(ss * (1.f / 128.f) + EPS);
      const size_t mrow = rowbase + t0 + i;
      const u32x4 o0 = *(const u32x4*)(PROJ + mrow * NPROJ + C_O + 128 * hd + e0), o1 = *(const u32x4*)(PROJ + mrow * NPROJ + C_O + 128 * hd + e0 + 8);
      const unsigned ow[8] = {o0.x, o0.y, o0.z, o0.w, o1.x, o1.y, o1.z, o1.w};
      unsigned res[8];
#pragma unroll
      for (int j = 0; j < 8; ++j) { const float g0 = hnorm[128 * hd + e0 + 2 * j], g1 = hnorm[128 * hd + e0 + 2 * j + 1];
          const float s0 = 1.f / (1.f + __expf(-bflo(ow[j]))), s1 = 1.f / (1.f + __expf(-bfhi(ow[j])));
          res[j] = pk2(v[2 * j] * rs * g0 * s0, v[2 * j + 1] * rs * g1 * s1); }
      bf16_t* op = HM + mrow * 1024 + 128 * hd + e0;
      *(u32x4*)op = (u32x4){res[0], res[1], res[2], res[3]}; *(u32x4*)(op + 8) = (u32x4){res[4], res[5], res[6], res[7]}; }
    __syncthreads();
}

struct Args { const float* in[18]; float* out; unsigned char* ws; int ph_lo, ph_hi; };
constexpr int PH_PER_LAYER = 11, N_PHASES = 1 + DEPTH * PH_PER_LAYER;

#define KAS __attribute__((address_space(4)))
#define KARG_P(i) (*(const float* const KAS*)(kp + 8 * (i)))
#define PH_BEGIN if (lo <= ph && ph < hi) { \
        const KAS char* kp = (const KAS char*)__builtin_amdgcn_kernarg_segment_ptr(); asm volatile("" : "+s"(kp)); \
        char* lds = (char*)lds_raw; PG8_LAS unsigned char* lds3 = (PG8_LAS unsigned char*)lds_raw; \
        const int tid = tid_opaque(wave_s); const int lane = tid & 63, wave = wave_s; \
        const int G = gridDim.x, bx = blockIdx.x; const int vcu = (G % 8 == 0) ? (bx % 8) * (G / 8) + bx / 8 : bx; \
        const int gw = vcu * NWAVES + wave, NGW = G * NWAVES; \
        unsigned char* ws = (unsigned char*)KARG_P(19); float* out = (float*)KARG_P(18); const float* x_in = KARG_P(0); \
        (void)lds; (void)lds3; (void)lane; (void)gw; (void)NGW; (void)out; (void)x_in; (void)vcu;
#define XB_HERE() do { XcdBarrier bb_; bb_.bar = (unsigned*)(ws + WS_BAR); bb_.x = xb_xcc_id(); bb_.st = (volatile LAS unsigned*)((LAS unsigned char*)lds_raw + MISC_OFF) + 8; xcd_barrier(bb_); } while (0)
#if PROBE_SYNC
#define PH_END   if (ph + 1 < hi) { XB_HERE(); XB_HERE(); } } ++ph;
#else
#define PH_END   if (ph + 1 < hi) { XB_HERE(); } } ++ph;
#endif
#define XN_   ((bf16_t*)(ws + WS_XN))
#define CS_   ((float*)(ws + WS_CS))
#define PROJ_ ((bf16_t*)(ws + WS_PROJ))
#define QB_   ((bf16_t*)(ws + WS_Q))
#define KB_   ((bf16_t*)(ws + WS_K))
#define VT_   ((bf16_t*)(ws + WS_VT))
#define HB_   ((bf16_t*)(ws + WS_H))
#define MIX_  ((bf16_t*)(ws + WS_MIX))
#define HM_   ((bf16_t*)(ws + WS_HM))
#define YB_   ((bf16_t*)(ws + WS_Y))
#define CQN_  ((bf16_t*)(ws + WS_CQN))
#define CKVN_ ((bf16_t*)(ws + WS_CKVN))
#define COS_  ((float*)(ws + WS_COS))
#define SIN_  ((float*)(ws + WS_SIN))
#define MLOC_ ((float*)(ws + WS_MLOC))
#define BEND_ ((float*)(ws + WS_BEND))
#define MPREV_ ((float*)(ws + WS_MPREV))
#define NLOC_ ((float*)(ws + WS_NLOC))
#define WL_(off) ((const bf16_t*)(ws + WS_W + (size_t)l * W_LAYER + (off)))

template <int L> DI void layer_phases(cg::grid_group grid, const int lo, const int hi, int& ph, const int wave_s) {
    extern __shared__ __attribute__((aligned(16))) unsigned char lds_raw[];
    constexpr int l = L;
        PH_BEGIN
            pg8::Gemm g{XN_, WL_(W_IN), M, NPROJ, DM}; pg8::StaticOrder S; S.init(M, NPROJ, G, bx);
            EpiStore<0> E{PROJ_, NPROJ};
#ifndef SKIP_G1
            for (int rep_g = 0; rep_g < 1 + PROBE_GEMM; ++rep_g)
            pg8::gemm_phase<EpiStore<0>, pg8::StaticOrder, true, true>(lds3, g, S, E, wave_s);
#endif
        PH_END
        PH_BEGIN
            for (int rep_p = 0; rep_p < 1 + PROBE_ROW; ++rep_p)
            prep_rows(PROJ_, KARG_P(8) + l * 256, KARG_P(10) + l * 128, COS_, SIN_, CQN_, CKVN_, KB_, gw, NGW, lane);
        PH_END
        PH_BEGIN
            { int Kq = 256; asm volatile("" : "+s"(Kq)); pg8::Gemm g{CQN_, WL_(W_UQ), M, 768, Kq}; pg8::StaticOrder S; S.init(M, 768, G, bx);
              EpiQ E{QB_, COS_, SIN_};
#ifndef SKIP_G2
            for (int rep_g = 0; rep_g < 1 + PROBE_GEMM; ++rep_g)
              pg8::gemm_phase<EpiQ, pg8::StaticOrder, false, true>(lds3, g, S, E, wave_s);
#endif
            }
            { int Kk = 128; asm volatile("" : "+s"(Kk)); pg8::Gemm g{CKVN_, WL_(W_UKV), M, 1024, Kk}; pg8::StaticOrder S; S.init(M, 1024, G, bx);
              EpiKV E{KB_, VT_};
#ifndef SKIP_G3
            for (int rep_g = 0; rep_g < 1 + PROBE_GEMM; ++rep_g)
              pg8::gemm_phase<EpiKV, pg8::StaticOrder, false, true>(lds3, g, S, E, wave_s);
#endif
            }
        PH_END
        PH_BEGIN
#ifndef SKIP_ATTN
            for (int rep = 0; rep < 1 + PROBE_ATTN; ++rep)
            for (int p = vcu; p < 256; p += G) { const int b = p >> 7, head = (p >> 4) & 7, s = p & 15;
                ATTN_FN(QB_, KB_, VT_, HM_, b, head, 31 - s, lds, wave_s); ATTN_FN(QB_, KB_, VT_, HM_, b, head, s, lds, wave_s); }
#endif
#ifndef SKIP_ML
            for (int rep = 0; rep < 1 + PROBE_ML; ++rep)
            for (int u = vcu; u < 8 * NCH; u += G)
                mlstm_local_unit(PROJ_, KARG_P(5) + l * 4 * 512, KARG_P(6) + l * 512, KARG_P(4) + l * 8, CS_, NLOC_, MLOC_, BEND_, u >> 7, u & 127, lds, wave_s);
#endif
        PH_END
        PH_BEGIN
#ifndef SKIP_ML
            for (int j = bx; j < 8 * 17; j += G) mlstm_scan(CS_, NLOC_, MLOC_, BEND_, MPREV_, j, lds, wave_s);
#endif
        PH_END
        PH_BEGIN
#ifndef SKIP_ML
            for (int rep = 0; rep < 1 + PROBE_ML; ++rep)
            for (int u = vcu; u < 8 * NCH; u += G)
                mlstm_out_unit(PROJ_, KARG_P(5) + l * 4 * 512, KARG_P(6) + l * 512, KARG_P(4) + l * 8, KARG_P(7) + l * 512, CS_, NLOC_, MPREV_, HM_, u >> 7, u & 127, lds, wave_s);
#endif
        PH_END
        PH_BEGIN
            pg8::Gemm g{HM_, WL_(W_OUT), M, DM, DM}; pg8::StaticOrder S; S.init(M, DM, G, bx);
            EpiStore<0> E{MIX_, DM};
#ifndef SKIP_G4
            for (int rep_g = 0; rep_g < 1 + PROBE_GEMM; ++rep_g)
            pg8::gemm_phase<EpiStore<0>, pg8::StaticOrder, false, true>(lds3, g, S, E, wave_s);
#endif
        PH_END
        PH_BEGIN
#if PROBE_ROW
            row_pass(MIX_, (l == 0) ? x_in : out, KARG_P(13) + l * DM, (float*)(ws + 114 * MiB), KARG_P(14) + l * DM, (bf16_t*)(ws + 178 * MiB), gw, NGW, lane);
#endif
            row_pass(MIX_, (l == 0) ? x_in : out, KARG_P(13) + l * DM, out, KARG_P(14) + l * DM, XN_, gw, NGW, lane);
        PH_END
        PH_BEGIN
            pg8::Gemm g{XN_, WL_(W_UP), M, FF, DM}; pg8::StaticOrder S; S.init(M, FF, G, bx);
            EpiStore<2> E{HB_, FF};
#ifndef SKIP_G5
            for (int rep_g = 0; rep_g < 1 + PROBE_GEMM; ++rep_g)
            pg8::gemm_phase<EpiStore<2>, pg8::StaticOrder, true, true>(lds3, g, S, E, wave_s);
#endif
        PH_END
        PH_BEGIN
            pg8::Gemm g{HB_, WL_(W_DOWN), M, DM, FF}; pg8::StaticOrder S; S.init(M, DM, G, bx);
            EpiStore<0> E{YB_, DM};
#ifndef SKIP_G6
            for (int rep_g = 0; rep_g < 1 + PROBE_GEMM; ++rep_g)
            pg8::gemm_phase<EpiStore<0>, pg8::StaticOrder, false, true>(lds3, g, S, E, wave_s);
#endif
        PH_END
        PH_BEGIN
#if PROBE_ROW
            row_pass(YB_, out, KARG_P(17) + l * DM, (float*)(ws + 82 * MiB), (l + 1 < DEPTH) ? KARG_P(2) + (l + 1) * DM : nullptr, (bf16_t*)(ws + 146 * MiB), gw, NGW, lane);
#endif
            row_pass(YB_, out, KARG_P(17) + l * DM, out, (l + 1 < DEPTH) ? KARG_P(2) + (l + 1) * DM : nullptr, XN_, gw, NGW, lane);
        PH_END
    }

__global__ void __launch_bounds__(NTHR, 2) fwd_kernel(Args args) {
    extern __shared__ __attribute__((aligned(16))) unsigned char lds_raw[];
    cg::grid_group grid = cg::this_grid();
    const int lo = args.ph_lo, hi = args.ph_hi;
    const int wave_s = __builtin_amdgcn_readfirstlane((int)threadIdx.x >> 6);
    for (int u = threadIdx.x; u < (LDS_BYTES - 131072) / 4; u += NTHR) ((LAS unsigned*)((LAS unsigned char*)lds_raw + 131072))[u] = 0u;
    __syncthreads();
    (void)xcd_barrier_post((unsigned*)(args.ws + WS_BAR), (volatile LAS unsigned*)((LAS unsigned char*)lds_raw + MISC_OFF) + 8);
    if (hi < 0) grid.sync();
    int ph = 0;
    PH_BEGIN
        float* scr = (float*)(lds + wave * 16384);
        constexpr int I_IN = 16 * 64, I_UQ = 4 * 24, I_UKV = 2 * 32, I_OUT = 16 * 32, I_UP = 16 * 128, I_DN = 64 * 32, I_L = I_IN + I_UQ + I_UKV + I_OUT + I_UP + I_DN;
        for (int rep_w = 0; rep_w < 1 + PROBE_PRO; ++rep_w)
        for (int it = gw; it < DEPTH * I_L; it += NGW) {
            const int l = it / I_L; int rI = it % I_L; unsigned char* wl = ws + WS_W + (size_t)l * W_LAYER;
            if (rI < I_IN) { transpose_item(KARG_P(3) + (size_t)l * DM * INW, DM, INW, NPROJ, (bf16_t*)(wl + W_IN), scr, rI, lane); continue; } rI -= I_IN;
            if (rI < I_UQ) { transpose_item(KARG_P(9) + (size_t)l * 256 * 768, 256, 768, 768, (bf16_t*)(wl + W_UQ), scr, rI, lane); continue; } rI -= I_UQ;
            if (rI < I_UKV) { transpose_item(KARG_P(11) + (size_t)l * 128 * 1024, 128, 1024, 1024, (bf16_t*)(wl + W_UKV), scr, rI, lane); continue; } rI -= I_UKV;
            if (rI < I_OUT) { transpose_item(KARG_P(12) + (size_t)l * DM * DM, DM, DM, DM, (bf16_t*)(wl + W_OUT), scr, rI, lane); continue; } rI -= I_OUT;
            if (rI < I_UP) { transpose_item(KARG_P(15) + (size_t)l * DM * FF, DM, FF, FF, (bf16_t*)(wl + W_UP), scr, rI, lane); continue; } rI -= I_UP;
            transpose_item(KARG_P(16) + (size_t)l * FF * DM, FF, DM, DM, (bf16_t*)(wl + W_DOWN), scr, rI, lane);
        }
        rope_tables((const int*)KARG_P(1), COS_, SIN_, bx * NTHR + tid, G * NTHR);
        for (int rep_w = 0; rep_w < 1 + PROBE_PRO; ++rep_w)
        row_pass(nullptr, x_in, nullptr, nullptr, KARG_P(2), XN_, gw, NGW, lane);
    PH_END

    layer_phases<0>(grid, lo, hi, ph, wave_s);
    layer_phases<1>(grid, lo, hi, ph, wave_s);
#undef PH_BEGIN
#undef PH_END
}

#ifndef N_LAUNCH_MODE
#define N_LAUNCH_MODE 1
#endif
extern "C" void kernel_launch(void* const* d_in, const int* in_sizes, int n_in, void* d_out, int out_size, void* d_ws, size_t ws_size, hipStream_t stream) {
    static int grid = 0;
    if (grid == 0) {
        if (n_in != 18 || in_sizes[0] != M * DM || out_size != M * DM || ws_size < WS_END) { fprintf(stderr, "kernel_launch: unexpected shapes (n_in %d, in0 %d, out %d, ws %zu)\n", n_in, n_in > 0 ? in_sizes[0] : -1, out_size, ws_size); grid = -1; return; }
        int dev = 0, cus = 0, per_cu = 0;
        hipGetDevice(&dev); hipDeviceGetAttribute(&cus, hipDeviceAttributeMultiprocessorCount, dev);
        hipFuncSetAttribute((const void*)fwd_kernel, hipFuncAttributeMaxDynamicSharedMemorySize, LDS_BYTES);
        hipOccupancyMaxActiveBlocksPerMultiprocessor(&per_cu, (const void*)fwd_kernel, NTHR, LDS_BYTES);
        if (per_cu < 1) { fprintf(stderr, "kernel_launch: occupancy query says %d blocks per CU\n", per_cu); per_cu = 1; }
        (void)hipGetLastError();
        grid = cus;
    }
    if (grid < 0) return;
    Args a{};
    for (int i = 0; i < 18; ++i) a.in[i] = (const float*)d_in[i];
    a.out = (float*)d_out; a.ws = (unsigned char*)d_ws;
    (void)hipMemsetAsync((char*)d_ws + WS_BAR, 0, BAR_BYTES, stream);
#if N_LAUNCH_MODE == 1
    a.ph_lo = 0; a.ph_hi = N_PHASES;
    void* kargs[] = {&a};
    hipError_t e = hipLaunchCooperativeKernel((const void*)fwd_kernel, dim3(grid), dim3(NTHR), kargs, LDS_BYTES, stream);
    if (e != hipSuccess) fprintf(stderr, "cooperative launch failed: %s (grid %d)\n", hipGetErrorString(e), grid);
#else
    for (int p = 0; p < N_PHASES; ++p) { a.ph_lo = p; a.ph_hi = p + 1; hipLaunchKernelGGL(fwd_kernel, dim3(grid), dim3(NTHR), LDS_BYTES, stream, a); }
#endif
}
```
